# Optimizing an MI355X kernel written in HIP

```python
import math
import jax, jax.numpy as jnp
from jax import lax
import numpy as np

D_MODEL = 1024
BATCH = 4
SEQ = 8192
DEPTH = 2

N_EVEN = (DEPTH + 1) // 2
N_ODD = DEPTH // 2

LRU_WIDTH = D_MODEL
LRU_HEADS = 8
LRU_BLOCK = LRU_WIDTH // LRU_HEADS
CONV_WIDTH = 4
LRU_C = 8.0
SB_HEADS = 8
SB_HEAD_DIM = 128
SB_WIDTH = SB_HEADS * SB_HEAD_DIM
Q_BLOCK = 128
IN_EVEN = 2 * LRU_WIDTH + 4 * SB_WIDTH
OUT_EVEN = LRU_WIDTH + SB_WIDTH
S5_WIDTH = D_MODEL
S5_GROUP = 16
S5_GROUPS = S5_WIDTH // S5_GROUP
S5_STATE = 64
IN_ODD = 2 * S5_WIDTH

EPS = 1e-6

kernel_name = "hybrid_rglru_stickbreak_s5_trunk"


def rms_norm(x, g):
    x32 = x.astype(jnp.float32)
    y = x32 * lax.rsqrt(jnp.mean(x32 * x32, axis=-1, keepdims=True) + EPS)
    return (y * g.astype(jnp.float32)).astype(x.dtype)


def ada_modulate(x, c, g, w, b):
    mod = jax.nn.silu(c) @ w + b
    shift, scale, gate = jnp.split(mod, 3, axis=-1)
    h = rms_norm(x, g) * (1 + scale[:, None, :]) + shift[:, None, :]
    return h, gate[:, None, :]


def causal_depthwise_conv(x, w, b):
    width = x.shape[-1]
    y = lax.conv_general_dilated(
        x, w[:, None, :].astype(x.dtype), window_strides=(1,),
        padding=[(CONV_WIDTH - 1, 0)], dimension_numbers=("NWC", "WIO", "NWC"),
        feature_group_count=width)
    return y + b


def _linear_combine(e1, e2):
    a1, b1 = e1
    a2, b2 = e2
    return (a2 * a1, a2 * b1 + b2)


def rg_lru(x, wr, br, wi, bi, lam):
    bsz, slen, width = x.shape
    x32 = x.astype(jnp.float32)
    xh = x32.reshape(bsz, slen, LRU_HEADS, LRU_BLOCK)
    r = jax.nn.sigmoid(jnp.einsum("bshi,hij->bshj", xh, wr.astype(jnp.float32)).reshape(bsz, slen, width) + br)
    i = jax.nn.sigmoid(jnp.einsum("bshi,hij->bshj", xh, wi.astype(jnp.float32)).reshape(bsz, slen, width) + bi)
    log_a = LRU_C * r * jax.nn.log_sigmoid(lam.astype(jnp.float32))
    a = jnp.exp(log_a)
    b = jnp.sqrt(-jnp.expm1(2.0 * log_a)) * (i * x32)
    _, h = lax.associative_scan(_linear_combine, (a, b), axis=1)
    return h.astype(x.dtype)


def stick_breaking_attention(q, k, v):
    slen, dh = q.shape[1], q.shape[-1]
    q32 = q.astype(jnp.float32) * (dh ** -0.5)
    k32 = k.astype(jnp.float32)
    v32 = v.astype(jnp.float32)
    outs = []
    for blk in range(slen // Q_BLOCK):
        start = blk * Q_BLOCK
        end = start + Q_BLOCK
        qb = q32[:, start:end]
        kp = k32[:, :end]
        vp = v32[:, :end]
        z = jnp.einsum("bqhd,bkhd->bhqk", qb, kp)
        t_idx = start + jnp.arange(Q_BLOCK)[:, None]
        s_idx = jnp.arange(end)[None, :]
        mask = s_idx < t_idx
        log_keep = jnp.where(mask, jax.nn.log_sigmoid(-z), 0.0)
        later = lax.cumsum(log_keep, axis=3, reverse=True) - log_keep
        w = jnp.where(mask, jnp.exp(jax.nn.log_sigmoid(z) + later), 0.0)
        outs.append(jnp.einsum("bhqk,bkhd->bqhd", w, vp))
    return jnp.concatenate(outs, axis=1).astype(v.dtype)


def s5_ssm(u, lam_re, lam_im, log_dt, b_re, b_im, c_re, c_im, d_skip):
    bsz, slen, width = u.shape
    u32 = u.astype(jnp.float32)
    dt = jnp.exp(log_dt.astype(jnp.float32))[:, None]
    lam_re = lam_re.astype(jnp.float32)
    lam_im = lam_im.astype(jnp.float32)
    decay = jnp.exp(lam_re * dt)
    ang = lam_im * dt
    abar_re = decay * jnp.cos(ang)
    abar_im = decay * jnp.sin(ang)
    den = lam_re * lam_re + lam_im * lam_im
    num_re = abar_re - 1.0
    coef_re = (num_re * lam_re + abar_im * lam_im) / den
    coef_im = (abar_im * lam_re - num_re * lam_im) / den
    b_re = b_re.astype(jnp.float32)
    b_im = b_im.astype(jnp.float32)
    bbar_re = coef_re[..., None] * b_re - coef_im[..., None] * b_im
    bbar_im = coef_re[..., None] * b_im + coef_im[..., None] * b_re
    ug = u32.reshape(bsz, slen, S5_GROUPS, S5_GROUP)
    bu_re = jnp.einsum("bsgc,gpc->bsgp", ug, bbar_re)
    bu_im = jnp.einsum("bsgc,gpc->bsgp", ug, bbar_im)
    a_re = jnp.broadcast_to(abar_re, (1, slen, S5_GROUPS, S5_STATE))
    a_im = jnp.broadcast_to(abar_im, (1, slen, S5_GROUPS, S5_STATE))

    def complex_combine(e1, e2):
        a1r, a1i, b1r, b1i = e1
        a2r, a2i, b2r, b2i = e2
        return (a2r * a1r - a2i * a1i,
                a2r * a1i + a2i * a1r,
                a2r * b1r - a2i * b1i + b2r,
                a2r * b1i + a2i * b1r + b2i)

    _, _, h_re, h_im = lax.associative_scan(complex_combine, (a_re, a_im, bu_re, bu_im), axis=1)
    y = (jnp.einsum("bsgp,gcp->bsgc", h_re, c_re.astype(jnp.float32))
         - jnp.einsum("bsgp,gcp->bsgc", h_im, c_im.astype(jnp.float32)))
    y = y.reshape(bsz, slen, width) + d_skip.astype(jnp.float32) * u32
    return y.astype(u.dtype)


def even_mixer(h, w_in, conv_w, conv_b, wr, br, wi, bi, lam, q_g, k_g, w_out):
    bsz, slen, _ = h.shape
    proj = h @ w_in
    o1 = LRU_WIDTH
    o2 = 2 * LRU_WIDTH
    xa, ga, q, k, v, gb = jnp.split(
        proj, [o1, o2, o2 + SB_WIDTH, o2 + 2 * SB_WIDTH, o2 + 3 * SB_WIDTH], axis=-1)
    ya = rg_lru(causal_depthwise_conv(xa, conv_w, conv_b), wr, br, wi, bi, lam) * jax.nn.silu(ga)
    q = rms_norm(q.reshape(bsz, slen, SB_HEADS, SB_HEAD_DIM), q_g)
    k = rms_norm(k.reshape(bsz, slen, SB_HEADS, SB_HEAD_DIM), k_g)
    v = v.reshape(bsz, slen, SB_HEADS, SB_HEAD_DIM)
    yb = stick_breaking_attention(q, k, v).reshape(bsz, slen, SB_WIDTH) * jax.nn.silu(gb)
    return jnp.concatenate([ya, yb], axis=-1) @ w_out


def odd_mixer(h, w_in, lam_re, lam_im, log_dt, b_re, b_im, c_re, c_im, d_skip, glu_w, glu_b, w_out):
    u, g = jnp.split(h @ w_in, 2, axis=-1)
    y = jax.nn.gelu(s5_ssm(u, lam_re, lam_im, log_dt, b_re, b_im, c_re, c_im, d_skip))
    y = y * jax.nn.sigmoid(y @ glu_w + glu_b)
    return (y * jax.nn.silu(g)) @ w_out


def setup_inputs(seed: int = 0) -> dict:
    key = jax.random.key(seed)
    ks = jax.random.split(key, 32)
    f32 = jnp.float32
    nrm = lambda k, shape, s: jax.random.normal(k, shape, f32) * s
    a0 = jax.random.uniform(ks[12], (N_EVEN, LRU_WIDTH), f32, 0.9, 0.999)
    sig = a0 ** (1.0 / LRU_C)
    lru_lambda = jnp.log(sig) - jnp.log1p(-sig)
    n_idx = jnp.arange(S5_STATE, dtype=f32)
    return {
        "x": nrm(ks[0], (BATCH, SEQ, D_MODEL), 1.0),
        "c": nrm(ks[1], (BATCH, D_MODEL), 1.0),
        "norm_g": 1.0 + nrm(ks[2], (DEPTH, D_MODEL), 0.02),
        "ada_w": nrm(ks[3], (DEPTH, D_MODEL, 3 * D_MODEL), 0.5 * D_MODEL ** -0.5),
        "ada_b": nrm(ks[4], (DEPTH, 3 * D_MODEL), 0.01),
        "w_in_even": nrm(ks[5], (N_EVEN, D_MODEL, IN_EVEN), D_MODEL ** -0.5),
        "conv_w": nrm(ks[6], (N_EVEN, CONV_WIDTH, LRU_WIDTH), CONV_WIDTH ** -0.5),
        "conv_b": nrm(ks[7], (N_EVEN, LRU_WIDTH), 0.01),
        "lru_wr": nrm(ks[8], (N_EVEN, LRU_HEADS, LRU_BLOCK, LRU_BLOCK), LRU_BLOCK ** -0.5),
        "lru_br": nrm(ks[9], (N_EVEN, LRU_WIDTH), 0.01),
        "lru_wi": nrm(ks[10], (N_EVEN, LRU_HEADS, LRU_BLOCK, LRU_BLOCK), LRU_BLOCK ** -0.5),
        "lru_bi": nrm(ks[11], (N_EVEN, LRU_WIDTH), 0.01),
        "lru_lambda": lru_lambda,
        "q_norm_g": 1.0 + nrm(ks[13], (N_EVEN, SB_HEAD_DIM), 0.02),
        "k_norm_g": 1.0 + nrm(ks[14], (N_EVEN, SB_HEAD_DIM), 0.02),
        "w_out_even": nrm(ks[15], (N_EVEN, OUT_EVEN, D_MODEL), OUT_EVEN ** -0.5),
        "w_in_odd": nrm(ks[16], (N_ODD, D_MODEL, IN_ODD), D_MODEL ** -0.5),
        "s5_lambda_re": -0.5 + nrm(ks[17], (N_ODD, S5_GROUPS, S5_STATE), 0.01),
        "s5_lambda_im": math.pi * n_idx + nrm(ks[18], (N_ODD, S5_GROUPS, S5_STATE), 0.01),
        "s5_log_dt": jax.random.uniform(ks[19], (N_ODD, S5_GROUPS), f32, math.log(1e-3), math.log(1e-1)),
        "s5_b_re": nrm(ks[20], (N_ODD, S5_GROUPS, S5_STATE, S5_GROUP), (2 * S5_GROUP) ** -0.5),
        "s5_b_im": nrm(ks[21], (N_ODD, S5_GROUPS, S5_STATE, S5_GROUP), (2 * S5_GROUP) ** -0.5),
        "s5_c_re": nrm(ks[22], (N_ODD, S5_GROUPS, S5_GROUP, S5_STATE), S5_STATE ** -0.5),
        "s5_c_im": nrm(ks[23], (N_ODD, S5_GROUPS, S5_GROUP, S5_STATE), S5_STATE ** -0.5),
        "s5_d": nrm(ks[24], (N_ODD, S5_WIDTH), 1.0),
        "glu_w": nrm(ks[25], (N_ODD, S5_WIDTH, S5_WIDTH), S5_WIDTH ** -0.5),
        "glu_b": nrm(ks[26], (N_ODD, S5_WIDTH), 0.01),
        "w_out_odd": nrm(ks[27], (N_ODD, S5_WIDTH, D_MODEL), S5_WIDTH ** -0.5),
    }


def reference(x, c, norm_g, ada_w, ada_b, w_in_even, conv_w, conv_b, lru_wr, lru_br,
              lru_wi, lru_bi, lru_lambda, q_norm_g, k_norm_g, w_out_even, w_in_odd,
              s5_lambda_re, s5_lambda_im, s5_log_dt, s5_b_re, s5_b_im, s5_c_re, s5_c_im,
              s5_d, glu_w, glu_b, w_out_odd):
    for layer in range(DEPTH):
        h, gate = ada_modulate(x, c, norm_g[layer], ada_w[layer], ada_b[layer])
        j = layer // 2
        if layer % 2 == 0:
            out = even_mixer(h, w_in_even[j], conv_w[j], conv_b[j], lru_wr[j], lru_br[j],
                             lru_wi[j], lru_bi[j], lru_lambda[j], q_norm_g[j], k_norm_g[j],
                             w_out_even[j])
        else:
            out = odd_mixer(h, w_in_odd[j], s5_lambda_re[j], s5_lambda_im[j], s5_log_dt[j],
                            s5_b_re[j], s5_b_im[j], s5_c_re[j], s5_c_im[j], s5_d[j],
                            glu_w[j], glu_b[j], w_out_odd[j])
        x = x + gate * out
    return x
```

```cpp
#include <hip/hip_runtime.h>
#include <hip/hip_cooperative_groups.h>
#include <cstdio>
#include <cstdint>
namespace cg = cooperative_groups;

#define LAS __attribute__((address_space(3)))
typedef unsigned short bf16_t;
typedef short bf16x8 __attribute__((ext_vector_type(8)));
typedef float f32x4 __attribute__((ext_vector_type(4)));
typedef float f32x2 __attribute__((ext_vector_type(2)));
typedef unsigned u32x4 __attribute__((ext_vector_type(4)));
typedef unsigned u32x2 __attribute__((ext_vector_type(2)));

constexpr int SEQ = 8192, NB = 4, T = NB * SEQ, D = 1024;
constexpr float EPS = 1e-6f;
constexpr float QSCALE = 0.08838834764831845f * 1.4426950408889634f;
#ifndef REP_LRU
#define REP_LRU 1
#endif
#ifndef REP_ATT
#define REP_ATT 1
#endif
#ifndef REP_S5
#define REP_S5 1
#endif
#ifndef REP_G7
#define REP_G7 1
#endif
#ifndef REP_GALL
#define REP_GALL 1
#endif
#ifndef REP_NORM
#define REP_NORM 1
#endif
constexpr int LRU_NC = 8, LRU_LC = SEQ / LRU_NC;
constexpr int S5_LC = 512, S5_NC = SEQ / S5_LC;

constexpr size_t MiB = 1u << 20;
constexpr size_t WS_MOD = 1 * MiB;
constexpr size_t WS_ABAR = WS_MOD + 128 * 1024;
constexpr size_t WS_ABARL = WS_ABAR + 32 * 1024;
constexpr size_t WS_BBM = WS_ABARL + 32 * 1024;
constexpr size_t WS_CM = WS_BBM + 256 * 1024;
constexpr size_t WS_AB16 = 1 * MiB + 768 * 1024;
constexpr size_t WS_WG = 2 * MiB;
constexpr size_t WS_LAGG = WS_WG + 512 * 1024;
constexpr size_t WS_SAGG = 4 * MiB;
constexpr size_t WS_WINE = 8 * MiB;
constexpr size_t WS_WOUTE = 20 * MiB;
constexpr size_t WS_WINO = 24 * MiB;
constexpr size_t WS_WGLU = 28 * MiB;
constexpr size_t WS_WOUTO = 30 * MiB;
constexpr size_t WS_H = 32 * MiB;
constexpr size_t WS_XA = 96 * MiB;
constexpr size_t WS_GA = 160 * MiB;
constexpr size_t WS_Q = 224 * MiB;
constexpr size_t WS_K = 288 * MiB;
constexpr size_t WS_VT = 352 * MiB;
constexpr size_t WS_GB = 416 * MiB;
constexpr size_t WS_W16 = 480 * MiB;
constexpr size_t WS_END = 484 * MiB;

constexpr int XCH_OFF = 131072;
constexpr int BARST_OFF = XCH_OFF + 8192;
constexpr int LDS_BYTES = 147456;

__device__ __forceinline__ unsigned cvt_pk_bf16(float lo, float hi) { unsigned r; asm volatile("v_cvt_pk_bf16_f32 %0, %1, %2" : "=v"(r) : "v"(lo), "v"(hi)); return r; }
__device__ __forceinline__ unsigned f2bf(float f) { unsigned u = __float_as_uint(f); return (u + 0x7fffu + ((u >> 16) & 1u)) >> 16; }
__device__ __forceinline__ float bflo(unsigned w) { return __uint_as_float(w << 16); }
__device__ __forceinline__ float bfhi(unsigned w) { return __uint_as_float(w & 0xffff0000u); }
__device__ __forceinline__ float sigmoidf_(float x) { return __builtin_amdgcn_rcpf(1.0f + __expf(-x)); }
__device__ __forceinline__ float siluf_(float x) { return x * sigmoidf_(x); }
__device__ __forceinline__ float wave_sum(float v) {
#pragma unroll
    for (int o = 1; o < 64; o <<= 1) v += __shfl_xor(v, o);
    return v;
}
#define LDS_WAIT() asm volatile("s_waitcnt lgkmcnt(0)" ::: "memory")

struct Params { const float* in[28]; float* out; unsigned char* ws; };

namespace pg8 {
constexpr int BM = 256, BK = 64, HALF = 128, HTB = HALF * BK * 2, NXCD = 8, WGM = 8;
__device__ __forceinline__ int lds_byte(int r, int c) { const int st = (r >> 4) * 2 + (c >> 5), rr = r & 15, cc = c & 31, ob = rr * 64 + cc * 2; return st * 1024 + (ob ^ (((ob >> 9) & 1) << 5)); }
__device__ __forceinline__ void stage_rc(int b, int& R, int& C) { const int st = b / 1024, sb = b % 1024, swz = sb ^ (((sb >> 9) & 1) << 5); R = (st >> 1) * 16 + swz / 64; C = (st & 1) * 32 + (swz % 64) / 2; }
__device__ __forceinline__ int perm32(int rho) { const int n = rho >> 4, i = rho & 15; return 8 * (i >> 2) + 4 * n + (i & 3); }
struct Unit { int pm, pn; };
struct Gemm { const bf16_t* A; const bf16_t* A2; const bf16_t* Bt; int M, N, K, lda, ks; };
struct StaticOrder {
    int nM, nN, nwg, G, c;
    __device__ void init(int M, int N, int G_, int c_) { nM = M / BM; nN = N / BM; nwg = nM * nN; G = G_; c = c_; }
    __device__ bool next(int i, Unit& u) const {
        const long L = (long)i * G + c; if (L >= nwg) return false;
        int wgid = (int)L; { const int q = nwg / NXCD, r = nwg % NXCD, xcd = wgid % NXCD, off = wgid / NXCD; wgid = (xcd < r ? xcd * (q + 1) : r * (q + 1) + (xcd - r) * q) + off; }
        const int nig = WGM * nN, gid = wgid / nig, fm = gid * WGM, gsz = (nM - fm) < WGM ? (nM - fm) : WGM;
        u.pm = fm + ((wgid % nig) % gsz); u.pn = (wgid % nig) / gsz; return true;
    }
};

template <class Epi, bool ALIGN_EPI = true, bool SP2 = true>
__device__ __forceinline__ void gemm_phase(LAS unsigned char* lds, const Gemm g, const StaticOrder& S, const Epi& E) {
    int tid_ = threadIdx.x; asm volatile("" : "+v"(tid_));
    const int tid = tid_, wid = __builtin_amdgcn_readfirstlane(tid >> 6), lane = tid & 63, wr = wid >> 2, wc = wid & 3, fr = lane & 15, fq = lane >> 4;
    const int K = g.K, nt = K / BK;
    unsigned voffA[2], voffB[2];
#pragma unroll
    for (int i = 0; i < 2; ++i) { int R, C; stage_rc(tid * 16 + i * 8192, R, C); const int Rb = Epi::PERM ? ((R & ~31) + perm32(R & 31)) : R;
        voffA[i] = (unsigned)(R * g.lda + C) * 2u; voffB[i] = (unsigned)(Rb * K + C) * 2u; }
    const size_t kstep = (size_t)(BK * 2);
    const size_t hstepA = (size_t)HALF * g.lda * 2, hstepB = (size_t)HALF * K * 2;
    const size_t tstepA = 2 * hstepA, tstepB = 2 * hstepB;
    const unsigned ldsw = (unsigned)wid * 1024u;
    const int aoff = lds_byte(wr * 64 + fr, fq * 8), boff = lds_byte(wc * 32 + fr, fq * 8);
#define PG8_ATILE(pm, t) (((t) < g.ks ? (const char*)g.A + (size_t)(t) * kstep : (const char*)g.A2 + (size_t)((t) - g.ks) * kstep) + (size_t)(pm) * tstepA)
#define PG8_SA(b, h) (((b) * 2 + (h)) * HTB)
#define PG8_SB(b, h) ((4 + (b) * 2 + (h)) * HTB)
#define PG8_STAGE(bufoff, gbase, voff) do { _Pragma("unroll") for (int _i = 0; _i < 2; ++_i) \
        __builtin_amdgcn_global_load_lds((const unsigned*)((const char*)(gbase) + (voff)[_i]), (LAS unsigned*)(lds + (bufoff) + ldsw + _i * 8192), 16, 0, 0); } while (0)
#define PG8_LDA(dst, b, h) do { _Pragma("unroll") for (int m = 0; m < 4; ++m) _Pragma("unroll") for (int k = 0; k < 2; ++k) dst[m][k] = *(const LAS bf16x8*)(lds + PG8_SA(b, h) + aoff + m * 2048 + k * 1024); } while (0)
#define PG8_LDB(dst, b, h) do { _Pragma("unroll") for (int n = 0; n < 2; ++n) _Pragma("unroll") for (int k = 0; k < 2; ++k) dst[n][k] = *(const LAS bf16x8*)(lds + PG8_SB(b, h) + boff + n * 2048 + k * 1024); } while (0)
#define PG8_MMA(ai, bj, At, Bt) do { __builtin_amdgcn_s_setprio(1); _Pragma("unroll") for (int m = 0; m < 4; ++m) _Pragma("unroll") for (int n = 0; n < 2; ++n) _Pragma("unroll") for (int k = 0; k < 2; ++k) \
        acc[ai][bj][m][n] = __builtin_amdgcn_mfma_f32_16x16x32_bf16(Bt[n][k], At[m][k], acc[ai][bj][m][n], 0, 0, 0); __builtin_amdgcn_s_setprio(0); } while (0)
#define PG8_WAIT_V(n) asm volatile("s_waitcnt vmcnt(" #n ")" ::: "memory")
#define PG8_WAIT_L(n) asm volatile("s_waitcnt lgkmcnt(" #n ")" ::: "memory")
#define PG8_BAR __builtin_amdgcn_s_barrier()
#define PG8_SCHED __builtin_amdgcn_sched_barrier(0)
    Unit cur, nxt; int ui = 0;
    if (!S.next(0, cur)) return;
    f32x4 acc[2][2][4][2];
#pragma unroll
    for (int a = 0; a < 2; ++a)
#pragma unroll
        for (int b = 0; b < 2; ++b)
#pragma unroll
            for (int m = 0; m < 4; ++m)
#pragma unroll
                for (int n = 0; n < 2; ++n) acc[a][b][m][n] = (f32x4){0.f, 0.f, 0.f, 0.f};
    bf16x8 At[4][2], B0[2][2], B1[2][2];
    const char* cB = (const char*)g.Bt + (size_t)cur.pn * tstepB;
    {
        const char* cA0 = PG8_ATILE(cur.pm, 0); const char* cA1 = PG8_ATILE(cur.pm, 1);
        if constexpr (SP2) {
            PG8_STAGE(PG8_SB(0, 0), cB, voffB); PG8_STAGE(PG8_SB(0, 1), cB + hstepB, voffB); PG8_STAGE(PG8_SA(0, 0), cA0, voffA); PG8_STAGE(PG8_SA(0, 1), cA0 + hstepA, voffA);
            if (wr == 1) PG8_BAR;
            PG8_WAIT_V(2); PG8_BAR;
            PG8_STAGE(PG8_SB(1, 0), cB + kstep, voffB); PG8_STAGE(PG8_SA(1, 0), cA1, voffA); PG8_STAGE(PG8_SB(1, 1), cB + hstepB + kstep, voffB);
            PG8_WAIT_V(6); PG8_BAR;
        } else {
            PG8_STAGE(PG8_SB(0, 0), cB, voffB); PG8_STAGE(PG8_SA(0, 0), cA0, voffA); PG8_STAGE(PG8_SB(0, 1), cB + hstepB, voffB); PG8_STAGE(PG8_SA(0, 1), cA0 + hstepA, voffA);
            if (wr == 1) PG8_BAR;
            PG8_WAIT_V(4); PG8_BAR;
            PG8_STAGE(PG8_SB(1, 0), cB + kstep, voffB); PG8_STAGE(PG8_SA(1, 0), cA1, voffA); PG8_STAGE(PG8_SB(1, 1), cB + hstepB + kstep, voffB);
            PG8_WAIT_V(6); PG8_BAR;
        }
    }
    for (;;) {
        const bool has_next = S.next(ui + 1, nxt);
        const int npm = has_next ? nxt.pm : cur.pm;
        const char* nB = has_next ? (const char*)g.Bt + (size_t)nxt.pn * tstepB : cB;
        for (int t = 0; t < nt; t += 2) {
            const bool last = (t == nt - 2);
            const char* a1 = PG8_ATILE(cur.pm, t + 1);
            const char* a2 = last ? PG8_ATILE(npm, 0) : PG8_ATILE(cur.pm, t + 2);
            const char* a3 = last ? PG8_ATILE(npm, 1) : PG8_ATILE(cur.pm, t + 3);
            const char* b2 = last ? nB : cB + (size_t)(t + 2) * kstep;
            const char* b3 = b2 + kstep;
            if constexpr (SP2) {
            PG8_LDB(B0, 0, 0); PG8_LDB(B1, 0, 1); PG8_SCHED; PG8_LDA(At, 0, 0); PG8_STAGE(PG8_SA(1, 1), a1 + hstepA, voffA);
            PG8_WAIT_V(8); PG8_WAIT_L(0); PG8_BAR; PG8_MMA(0, 0, At, B0); PG8_MMA(0, 1, At, B1); PG8_BAR; PG8_SCHED;
            PG8_LDA(At, 0, 1); PG8_STAGE(PG8_SB(0, 0), b2, voffB); PG8_STAGE(PG8_SB(0, 1), b2 + hstepB, voffB); PG8_STAGE(PG8_SA(0, 0), a2, voffA);
            PG8_WAIT_V(8); PG8_WAIT_L(0); PG8_BAR; PG8_MMA(1, 0, At, B0); PG8_MMA(1, 1, At, B1); PG8_BAR; PG8_SCHED;
            PG8_LDB(B0, 1, 0); PG8_LDB(B1, 1, 1); PG8_SCHED; PG8_LDA(At, 1, 0); PG8_STAGE(PG8_SA(0, 1), a2 + hstepA, voffA);
            PG8_WAIT_V(8); PG8_WAIT_L(0); PG8_BAR; PG8_MMA(0, 0, At, B0); PG8_MMA(0, 1, At, B1); PG8_BAR; PG8_SCHED;
            PG8_LDA(At, 1, 1); PG8_STAGE(PG8_SB(1, 0), b3, voffB); PG8_STAGE(PG8_SB(1, 1), b3 + hstepB, voffB); PG8_STAGE(PG8_SA(1, 0), a3, voffA);
            PG8_WAIT_V(8); PG8_WAIT_L(0); PG8_BAR; PG8_MMA(1, 0, At, B0); PG8_MMA(1, 1, At, B1); PG8_BAR; PG8_SCHED;
            } else {
            PG8_LDB(B0, 0, 0); PG8_SCHED; PG8_LDA(At, 0, 0); PG8_STAGE(PG8_SA(1, 1), a1 + hstepA, voffA);
            PG8_WAIT_L(8); PG8_BAR; PG8_WAIT_L(0); PG8_MMA(0, 0, At, B0); PG8_BAR; PG8_SCHED;
            PG8_LDB(B1, 0, 1); PG8_STAGE(PG8_SB(0, 0), b2, voffB);
            PG8_BAR; PG8_WAIT_L(0); PG8_MMA(0, 1, At, B1); PG8_BAR;
            PG8_LDA(At, 0, 1); PG8_STAGE(PG8_SA(0, 0), a2, voffA);
            PG8_BAR; PG8_WAIT_L(0); PG8_MMA(1, 0, At, B0); PG8_BAR; PG8_SCHED;
            PG8_STAGE(PG8_SB(0, 1), b2 + hstepB, voffB);
            PG8_WAIT_V(6); PG8_BAR; PG8_MMA(1, 1, At, B1); PG8_BAR;
            PG8_LDB(B0, 1, 0); PG8_SCHED; PG8_LDA(At, 1, 0); PG8_STAGE(PG8_SA(0, 1), a2 + hstepA, voffA);
            PG8_WAIT_L(8); PG8_BAR; PG8_WAIT_L(0); PG8_MMA(0, 0, At, B0); PG8_BAR; PG8_SCHED;
            PG8_LDB(B1, 1, 1); PG8_STAGE(PG8_SB(1, 0), b3, voffB);
            PG8_BAR; PG8_WAIT_L(0); PG8_MMA(0, 1, At, B1); PG8_BAR;
            PG8_LDA(At, 1, 1); PG8_STAGE(PG8_SA(1, 0), a3, voffA);
            PG8_BAR; PG8_WAIT_L(0); PG8_MMA(1, 0, At, B0); PG8_BAR; PG8_SCHED;
            PG8_STAGE(PG8_SB(1, 1), b3 + hstepB, voffB);
            PG8_WAIT_V(6); PG8_BAR; PG8_MMA(1, 1, At, B1); PG8_BAR;
                    }
        }
        if constexpr (ALIGN_EPI) { if (wr == 0) PG8_BAR; }
        E(acc, cur, wr, wc, fr, fq, lds);
        if (!has_next) break;
#pragma unroll
        for (int a = 0; a < 2; ++a)
#pragma unroll
            for (int b = 0; b < 2; ++b)
#pragma unroll
                for (int m = 0; m < 4; ++m)
#pragma unroll
                    for (int n = 0; n < 2; ++n) acc[a][b][m][n] = (f32x4){0.f, 0.f, 0.f, 0.f};
        cur = nxt; cB = nB; ++ui;
        if constexpr (ALIGN_EPI) { if (wr == 1) PG8_BAR; }
    }
    PG8_WAIT_V(0);
    if constexpr (!ALIGN_EPI) { if (wr == 0) PG8_BAR; }
    PG8_BAR;
#undef PG8_ATILE
#undef PG8_SA
#undef PG8_SB
#undef PG8_STAGE
#undef PG8_LDA
#undef PG8_LDB
#undef PG8_MMA
#undef PG8_WAIT_V
#undef PG8_WAIT_L
#undef PG8_BAR
#undef PG8_SCHED
}

__device__ __forceinline__ void store8(bf16_t* p, const f32x4 v0, const f32x4 v1) {
    u32x4 w; w.x = cvt_pk_bf16(v0[0], v0[1]); w.y = cvt_pk_bf16(v0[2], v0[3]); w.z = cvt_pk_bf16(v1[0], v1[1]); w.w = cvt_pk_bf16(v1[2], v1[3]);
    *(u32x4*)p = w;
}
struct EpiInE {
    static constexpr bool PERM = true;
    bf16_t *XA, *GA, *Q, *K, *GB; const float *qg, *kg;
    __device__ __forceinline__ void operator()(f32x4 (&acc)[2][2][4][2], const Unit& u, int wr, int wc, int fr, int fq, LAS unsigned char* lds) const {
        const int seg = u.pn >> 2, colt = (u.pn & 3) * 256;
        const int row0 = u.pm * BM + wr * 64 + fr;
        const int col0 = colt + wc * 32 + 8 * fq;
        bf16_t* base = seg == 0 ? XA : seg == 1 ? GA : seg == 2 ? Q : seg == 3 ? K : GB;
        if (seg == 2 || seg == 3) {
            LAS float* X = (LAS float*)(lds + XCH_OFF);
#pragma unroll
            for (int ai = 0; ai < 2; ++ai)
#pragma unroll
                for (int m = 0; m < 4; ++m)
#pragma unroll
                    for (int bj = 0; bj < 2; ++bj) {
                        const f32x4 a = acc[ai][bj][m][0], b = acc[ai][bj][m][1];
                        float s = (a[0] * a[0] + a[1] * a[1]) + (a[2] * a[2] + a[3] * a[3]) + (b[0] * b[0] + b[1] * b[1]) + (b[2] * b[2] + b[3] * b[3]);
                        s += __shfl_xor(s, 16); s += __shfl_xor(s, 32);
                        if (fq == 0) X[((wr * 2 + bj) * 128 + ai * 64 + m * 16 + fr) * 4 + wc] = s;
                    }
            asm volatile("s_waitcnt lgkmcnt(0)" ::: "memory"); __builtin_amdgcn_s_barrier(); asm volatile("" ::: "memory");
            const float* gv = (seg == 2) ? qg : kg; const float sc = (seg == 2) ? QSCALE : 1.0f;
            const int hc = wc * 32 + 8 * fq;
            f32x4 g0 = *(const f32x4*)(gv + hc), g1 = *(const f32x4*)(gv + hc + 4);
            g0 = g0 * sc; g1 = g1 * sc;
#pragma unroll
            for (int ai = 0; ai < 2; ++ai)
#pragma unroll
                for (int m = 0; m < 4; ++m) {
                    bf16_t* rowp = base + (size_t)(row0 + ai * HALF + m * 16) * 1024 + col0;
#pragma unroll
                    for (int bj = 0; bj < 2; ++bj) {
                        const f32x4 t = *(const LAS f32x4*)(X + ((wr * 2 + bj) * 128 + ai * 64 + m * 16 + fr) * 4);
                        const float rstd = __builtin_amdgcn_rsqf(((t[0] + t[1]) + (t[2] + t[3])) * (1.0f / 128.0f) + EPS);
                        store8(rowp + bj * HALF, acc[ai][bj][m][0] * rstd * g0, acc[ai][bj][m][1] * rstd * g1);
                    }
                }
        } else {
            const bool act = (seg == 1 || seg == 4);
#pragma unroll
            for (int ai = 0; ai < 2; ++ai)
#pragma unroll
                for (int m = 0; m < 4; ++m) {
                    bf16_t* rowp = base + (size_t)(row0 + ai * HALF + m * 16) * 1024 + col0;
#pragma unroll
                    for (int bj = 0; bj < 2; ++bj) {
                        f32x4 v0 = acc[ai][bj][m][0], v1 = acc[ai][bj][m][1];
                        if (act) {
#pragma unroll
                            for (int j = 0; j < 4; ++j) { v0[j] = siluf_(v0[j]); v1[j] = siluf_(v1[j]); }
                        }
                        store8(rowp + bj * HALF, v0, v1);
                    }
                }
        }
    }
};
struct EpiSeg {
    static constexpr bool PERM = true;
    bf16_t* O0; bf16_t* O1; int ldc; int act1;
    __device__ __forceinline__ void operator()(f32x4 (&acc)[2][2][4][2], const Unit& u, int wr, int wc, int fr, int fq, LAS unsigned char* lds) const {
        const int seg = (u.pn * BM) / ldc >= 1 && O1 != nullptr ? 1 : 0;
        const int colt = (O1 != nullptr) ? (u.pn * BM - seg * ldc) : u.pn * BM;
        bf16_t* base = seg ? O1 : O0;
        const bool act = seg && (act1 & 1);
        const bool grp = !seg && (act1 & 2);
        const int row0 = u.pm * BM + wr * 64 + fr, col0 = colt + wc * 32 + 8 * fq;
#pragma unroll
        for (int ai = 0; ai < 2; ++ai)
#pragma unroll
            for (int m = 0; m < 4; ++m) {
                bf16_t* rowp = base + (size_t)(row0 + ai * HALF + m * 16) * ldc + col0;
#pragma unroll
                for (int bj = 0; bj < 2; ++bj) {
                    f32x4 v0 = acc[ai][bj][m][0], v1 = acc[ai][bj][m][1];
                    if (act) {
#pragma unroll
                        for (int j = 0; j < 4; ++j) { v0[j] = siluf_(v0[j]); v1[j] = siluf_(v1[j]); }
                    }
                    if (grp) { const int cc = col0 + bj * HALF; store8(base + ((size_t)(cc >> 4) * T + (row0 + ai * HALF + m * 16)) * 16 + (cc & 15), v0, v1); }
                    else store8(rowp + bj * HALF, v0, v1);
                }
            }
    }
};
struct EpiRes {
    static constexpr bool PERM = false;
    const float* base; float* out; const float* gate;
    __device__ __forceinline__ void operator()(f32x4 (&acc)[2][2][4][2], const Unit& u, int wr, int wc, int fr, int fq, LAS unsigned char* lds) const {
        const int b = (u.pm * BM) / SEQ;
        const int row0 = u.pm * BM + wr * 64 + fr, col0 = u.pn * BM + wc * 32 + 4 * fq;
        f32x4 gv[2][2];
#pragma unroll
        for (int bj = 0; bj < 2; ++bj)
#pragma unroll
            for (int n = 0; n < 2; ++n) gv[bj][n] = *(const f32x4*)(gate + b * 3072 + col0 + bj * HALF + n * 16);
#pragma unroll
        for (int ai = 0; ai < 2; ++ai) {
            f32x4 xv[4][2][2];
#pragma unroll
            for (int m = 0; m < 4; ++m) {
                const size_t off = (size_t)(row0 + ai * HALF + m * 16) * 1024 + col0;
#pragma unroll
                for (int bj = 0; bj < 2; ++bj)
#pragma unroll
                    for (int n = 0; n < 2; ++n) xv[m][bj][n] = *(const f32x4*)(base + off + bj * HALF + n * 16);
            }
#pragma unroll
            for (int m = 0; m < 4; ++m) {
                const size_t off = (size_t)(row0 + ai * HALF + m * 16) * 1024 + col0;
#pragma unroll
                for (int bj = 0; bj < 2; ++bj)
#pragma unroll
                    for (int n = 0; n < 2; ++n) *(f32x4*)(out + off + bj * HALF + n * 16) = xv[m][bj][n] + gv[bj][n] * acc[ai][bj][m][n];
            }
            asm volatile("" ::: "memory");
        }
    }
};
struct EpiResA {
    static constexpr bool PERM = true;
    const float* base; bf16_t* out; const float* gate;
    __device__ __forceinline__ void operator()(f32x4 (&acc)[2][2][4][2], const Unit& u, int wr, int wc, int fr, int fq, LAS unsigned char* lds) const {
        const int b = (u.pm * BM) / SEQ;
        const int row0 = u.pm * BM + wr * 64 + fr, col0 = u.pn * BM + wc * 32 + 8 * fq;
        f32x4 gv[2][2];
#pragma unroll
        for (int bj = 0; bj < 2; ++bj)
#pragma unroll
            for (int n = 0; n < 2; ++n) gv[bj][n] = *(const f32x4*)(gate + b * 3072 + col0 + bj * HALF + 4 * n);
#pragma unroll
        for (int ai = 0; ai < 2; ++ai) {
            f32x4 xv[4][2][2];
#pragma unroll
            for (int m = 0; m < 4; ++m) {
                const size_t off = (size_t)(row0 + ai * HALF + m * 16) * 1024 + col0;
#pragma unroll
                for (int bj = 0; bj < 2; ++bj)
#pragma unroll
                    for (int n = 0; n < 2; ++n) xv[m][bj][n] = *(const f32x4*)(base + off + bj * HALF + 4 * n);
            }
#pragma unroll
            for (int m = 0; m < 4; ++m) {
                const size_t off = (size_t)(row0 + ai * HALF + m * 16) * 1024 + col0;
#pragma unroll
                for (int bj = 0; bj < 2; ++bj) store8(out + off + bj * HALF, xv[m][bj][0] + gv[bj][0] * acc[ai][bj][m][0], xv[m][bj][1] + gv[bj][1] * acc[ai][bj][m][1]);
            }
            asm volatile("" ::: "memory");
        }
    }
};
struct EpiResB {
    static constexpr bool PERM = true;
    const bf16_t* base; float* out; const float* gate;
    __device__ __forceinline__ void operator()(f32x4 (&acc)[2][2][4][2], const Unit& u, int wr, int wc, int fr, int fq, LAS unsigned char* lds) const {
        const int b = (u.pm * BM) / SEQ;
        const int row0 = u.pm * BM + wr * 64 + fr, col0 = u.pn * BM + wc * 32 + 8 * fq;
        f32x4 gv[2][2];
#pragma unroll
        for (int bj = 0; bj < 2; ++bj)
#pragma unroll
            for (int n = 0; n < 2; ++n) gv[bj][n] = *(const f32x4*)(gate + b * 3072 + col0 + bj * HALF + 4 * n);
#pragma unroll
        for (int ai = 0; ai < 2; ++ai) {
            u32x4 xw[4][2];
#pragma unroll
            for (int m = 0; m < 4; ++m) {
                const size_t off = (size_t)(row0 + ai * HALF + m * 16) * 1024 + col0;
#pragma unroll
                for (int bj = 0; bj < 2; ++bj) xw[m][bj] = *(const u32x4*)(base + off + bj * HALF);
            }
#pragma unroll
            for (int m = 0; m < 4; ++m) {
                const size_t off = (size_t)(row0 + ai * HALF + m * 16) * 1024 + col0;
#pragma unroll
                for (int bj = 0; bj < 2; ++bj) {
                    const u32x4 w = xw[m][bj];
                    const f32x4 x0 = (f32x4){bflo(w.x), bfhi(w.x), bflo(w.y), bfhi(w.y)}, x1 = (f32x4){bflo(w.z), bfhi(w.z), bflo(w.w), bfhi(w.w)};
                    *(f32x4*)(out + off + bj * HALF) = x0 + gv[bj][0] * acc[ai][bj][m][0];
                    *(f32x4*)(out + off + bj * HALF + 4) = x1 + gv[bj][1] * acc[ai][bj][m][1];
                }
            }
            asm volatile("" ::: "memory");
        }
    }
};
struct EpiGlu {
    static constexpr bool PERM = true;
    const bf16_t* Y; const bf16_t* SG; bf16_t* O; const float* bias;
    __device__ __forceinline__ void operator()(f32x4 (&acc)[2][2][4][2], const Unit& u, int wr, int wc, int fr, int fq, LAS unsigned char* lds) const {
        const int row0 = u.pm * BM + wr * 64 + fr, col0 = u.pn * BM + wc * 32 + 8 * fq;
        f32x4 bv[2][2];
#pragma unroll
        for (int bj = 0; bj < 2; ++bj)
#pragma unroll
            for (int n = 0; n < 2; ++n) bv[bj][n] = *(const f32x4*)(bias + col0 + bj * HALF + 4 * n);
#pragma unroll
        for (int ai = 0; ai < 2; ++ai) {
            u32x4 ywv[4][2], swv[4][2];
#pragma unroll
            for (int m = 0; m < 4; ++m) {
                const size_t off = (size_t)(row0 + ai * HALF + m * 16) * 1024 + col0;
#pragma unroll
                for (int bj = 0; bj < 2; ++bj) { ywv[m][bj] = *(const u32x4*)(Y + off + bj * HALF); swv[m][bj] = *(const u32x4*)(SG + off + bj * HALF); }
            }
#pragma unroll
            for (int m = 0; m < 4; ++m) {
                const size_t off = (size_t)(row0 + ai * HALF + m * 16) * 1024 + col0;
#pragma unroll
                for (int bj = 0; bj < 2; ++bj) {
                    const u32x4 yw = ywv[m][bj], sw = swv[m][bj];
                    const f32x4 z0 = acc[ai][bj][m][0] + bv[bj][0], z1 = acc[ai][bj][m][1] + bv[bj][1];
                    f32x4 v0, v1;
                    v0[0] = bflo(yw.x) * bflo(sw.x) * sigmoidf_(z0[0]); v0[1] = bfhi(yw.x) * bfhi(sw.x) * sigmoidf_(z0[1]);
                    v0[2] = bflo(yw.y) * bflo(sw.y) * sigmoidf_(z0[2]); v0[3] = bfhi(yw.y) * bfhi(sw.y) * sigmoidf_(z0[3]);
                    v1[0] = bflo(yw.z) * bflo(sw.z) * sigmoidf_(z1[0]); v1[1] = bfhi(yw.z) * bfhi(sw.z) * sigmoidf_(z1[1]);
                    v1[2] = bflo(yw.w) * bflo(sw.w) * sigmoidf_(z1[2]); v1[3] = bfhi(yw.w) * bfhi(sw.w) * sigmoidf_(z1[3]);
                    store8(O + off + bj * HALF, v0, v1);
                }
            }
            asm volatile("" ::: "memory");
        }
    }
};
}

__device__ __forceinline__ void p0_transpose_item(const float* W, int N, bf16_t* WT, int ldk, int row_off, LAS float* scr, int kb, int nb, int lane) {
    const int k0 = 64 * kb, n0 = 32 * nb;
#pragma unroll 8
    for (int i = 0; i < 32; ++i) { const int kk = 2 * i + (lane >> 5); scr[kk * 33 + (lane & 31)] = W[(size_t)(k0 + kk) * N + n0 + (lane & 31)]; }
    LDS_WAIT();
    const int c = lane & 7;
#pragma unroll
    for (int j = 0; j < 4; ++j) { const int n = (lane >> 3) + 8 * j; const LAS float* s = scr + (8 * c) * 33 + n;
        u32x4 o; o.x = cvt_pk_bf16(s[0 * 33], s[1 * 33]); o.y = cvt_pk_bf16(s[2 * 33], s[3 * 33]); o.z = cvt_pk_bf16(s[4 * 33], s[5 * 33]); o.w = cvt_pk_bf16(s[6 * 33], s[7 * 33]);
        *(u32x4*)(WT + (size_t)(row_off + n0 + n) * ldk + k0 + 8 * c) = o; }
    LDS_WAIT();
}

__device__ __forceinline__ void p0_prologue(const Params& p, LAS unsigned char* lds) {
    int tidl_ = threadIdx.x; asm volatile("" : "+v"(tidl_));
    const int tid = tidl_, wave = tid >> 6, lane = tid & 63, G = gridDim.x;
    unsigned char* ws = p.ws;
    for (int it = blockIdx.x; it < 96; it += G) {
        LAS float* sc = (LAS float*)lds;
        LAS float* red = (LAS float*)(lds + 16384);
        const float* c = p.in[1];
        for (int i = tid; i < 4096; i += 512) { const float v = c[i]; sc[i] = v / (1.0f + expf(-v)); }
        __syncthreads();
        const int l = it / 48, n0 = (it % 48) * 64;
        const float* w = p.in[3] + (size_t)l * 1024 * 3072 + n0 + lane;
        float a0 = 0.f, a1 = 0.f, a2 = 0.f, a3 = 0.f;
#pragma unroll 8
        for (int kk = 0; kk < 128; ++kk) { const int k = wave * 128 + kk; const float wv = w[(size_t)k * 3072];
            a0 += wv * sc[k]; a1 += wv * sc[1024 + k]; a2 += wv * sc[2048 + k]; a3 += wv * sc[3072 + k]; }
        red[(wave * 4 + 0) * 64 + lane] = a0; red[(wave * 4 + 1) * 64 + lane] = a1; red[(wave * 4 + 2) * 64 + lane] = a2; red[(wave * 4 + 3) * 64 + lane] = a3;
        __syncthreads();
        if (tid < 256) { const int b = tid >> 6; float s = p.in[4][l * 3072 + n0 + lane];
#pragma unroll
            for (int w8 = 0; w8 < 8; ++w8) s += red[(w8 * 4 + b) * 64 + lane];
            ((float*)(ws + WS_MOD))[(l * 4 + b) * 3072 + n0 + lane] = s; }
        __syncthreads();
    }
}
__device__ __forceinline__ void p0_weights(const Params& p, LAS unsigned char* lds) {
    int tidl_ = threadIdx.x; asm volatile("" : "+v"(tidl_));
    const int tid = tidl_, wave = tid >> 6, lane = tid & 63, G = gridDim.x;
    unsigned char* ws = p.ws;
    {
        const int idx = (int)(gridDim.x - 1 - blockIdx.x) * 512 + tid;
        if (idx < 4096) {
            const int g = idx >> 6, pp = idx & 63;
            const double dt = exp((double)p.in[19][g]);
            const double lr = (double)p.in[17][idx], li = (double)p.in[18][idx];
            const double decay = exp(lr * dt), ang = li * dt;
            const double are = decay * cos(ang), aim = decay * sin(ang);
            const double den = lr * lr + li * li, nre = are - 1.0;
            const double cre = (nre * lr + aim * li) / den, cim = (aim * lr - nre * li) / den;
            float* AB = (float*)(ws + WS_ABAR); float* ABL = (float*)(ws + WS_ABARL);
            AB[idx * 2] = (float)are; AB[idx * 2 + 1] = (float)aim;
            { const double d16 = exp(lr * dt * 16.0), a16 = ang * 16.0; float* AB16 = (float*)(ws + WS_AB16); AB16[idx * 2] = (float)(d16 * cos(a16)); AB16[idx * 2 + 1] = (float)(d16 * sin(a16)); }
            const double dl = exp(lr * dt * S5_LC), al = ang * S5_LC;
            ABL[idx * 2] = (float)(dl * cos(al)); ABL[idx * 2 + 1] = (float)(dl * sin(al));
            bf16_t* BBM = (bf16_t*)(ws + WS_BBM); bf16_t* CM = (bf16_t*)(ws + WS_CM);
            for (int ch = 0; ch < 16; ++ch) {
                const double br = (double)p.in[20][(size_t)idx * 16 + ch], bi = (double)p.in[21][(size_t)idx * 16 + ch];
                BBM[((size_t)g * 128 + pp) * 16 + ch] = (bf16_t)f2bf((float)(cre * br - cim * bi));
                BBM[((size_t)g * 128 + 64 + pp) * 16 + ch] = (bf16_t)f2bf((float)(cre * bi + cim * br));
                CM[((size_t)g * 16 + ch) * 128 + 2 * pp] = (bf16_t)f2bf(p.in[22][((size_t)g * 16 + ch) * 64 + pp]);
                CM[((size_t)g * 16 + ch) * 128 + 2 * pp + 1] = (bf16_t)f2bf(-p.in[23][((size_t)g * 16 + ch) * 64 + pp]);
            }
        }
    }
    {
        LAS float* scr = (LAS float*)(lds + wave * 16384);
        const int nmod = (G > 128) ? 96 : 0;
        const int gw = ((int)blockIdx.x - nmod) * 8 + wave, NGW = (G - nmod) * 8;
        constexpr int I0 = 16 * 192, I1 = 32 * 32, I2 = 16 * 64, I3 = 16 * 32, I4 = 16 * 32, I5 = 64, I6 = 64;
        constexpr int NIT = I0 + I1 + I2 + I3 + I4 + I5 + I6;
        if (gw >= 0) for (int it = gw; it < NIT; it += NGW) {
            int r = it;
            if (r < I0) { const int kb = r / 192, nb = r % 192; const int n0 = nb * 32, seg = n0 >> 10; const int dseg = seg == 4 ? 5 : (seg == 5 ? 4 : seg);
                p0_transpose_item(p.in[5], 6144, (bf16_t*)(ws + WS_WINE), 1024, (dseg - seg) * 1024, scr, kb, nb, lane); continue; } r -= I0;
            if (r < I1) { p0_transpose_item(p.in[15], 1024, (bf16_t*)(ws + WS_WOUTE), 2048, 0, scr, r / 32, r % 32, lane); continue; } r -= I1;
            if (r < I2) { p0_transpose_item(p.in[16], 2048, (bf16_t*)(ws + WS_WINO), 1024, 0, scr, r / 64, r % 64, lane); continue; } r -= I2;
            if (r < I3) { p0_transpose_item(p.in[25], 1024, (bf16_t*)(ws + WS_WGLU), 1024, 0, scr, r / 32, r % 32, lane); continue; } r -= I3;
            if (r < I4) { p0_transpose_item(p.in[27], 1024, (bf16_t*)(ws + WS_WOUTO), 1024, 0, scr, r / 32, r % 32, lane); continue; } r -= I4;
            if (r < I5) { const int hh = r >> 3, q = r & 7; p0_transpose_item(p.in[8] + (size_t)hh * 16384, 128, (bf16_t*)(ws + WS_WG) + (size_t)hh * 256 * 128, 128, 0, scr, q >> 2, q & 3, lane); continue; } r -= I5;
            { const int hh = r >> 3, q = r & 7; p0_transpose_item(p.in[10] + (size_t)hh * 16384, 128, (bf16_t*)(ws + WS_WG) + (size_t)hh * 256 * 128, 128, 128, scr, q >> 2, q & 3, lane); }
        }
    }
}

__device__ __forceinline__ void norm_phase(const float* x, const float* ng, const float* mod, bf16_t* H) {
    int tidl_ = threadIdx.x; asm volatile("" : "+v"(tidl_));
    const int tid = tidl_, wave = tid >> 6, lane = tid & 63;
    const int gw = blockIdx.x * 8 + wave, NGW = gridDim.x * 8;
    const int R = (T + NGW - 1) / NGW;
    const int m0 = gw * R, m1 = (m0 + R < T) ? m0 + R : T;
    int curb = -1; f32x4 ca[4], cb[4];
    for (int m = m0; m < m1; m += 2) {
        const int b = m / SEQ;
        const bool two = (m + 1 < m1) && ((m + 1) / SEQ == b);
        if (b != curb) { curb = b;
#pragma unroll
            for (int j = 0; j < 4; ++j) { const int col = 4 * lane + 256 * j;
                const f32x4 g = *(const f32x4*)(ng + col), sc = *(const f32x4*)(mod + b * 3072 + 1024 + col);
                ca[j] = g * (sc + 1.0f); cb[j] = *(const f32x4*)(mod + b * 3072 + col); } }
        const f32x4* xr = (const f32x4*)(x + (size_t)m * D) + lane;
        const f32x4* xr2 = two ? xr + D / 4 : xr;
        f32x4 v[4], v2[4]; float ss = 0.f, ss2 = 0.f;
#pragma unroll
        for (int j = 0; j < 4; ++j) { v[j] = xr[64 * j]; v2[j] = xr2[64 * j]; }
#pragma unroll
        for (int j = 0; j < 4; ++j) { ss += (v[j][0] * v[j][0] + v[j][1] * v[j][1]) + (v[j][2] * v[j][2] + v[j][3] * v[j][3]);
            ss2 += (v2[j][0] * v2[j][0] + v2[j][1] * v2[j][1]) + (v2[j][2] * v2[j][2] + v2[j][3] * v2[j][3]); }
        const float rstd = 1.0f / sqrtf(wave_sum(ss) * (1.0f / D) + EPS), rstd2 = 1.0f / sqrtf(wave_sum(ss2) * (1.0f / D) + EPS);
        u32x2* o8 = (u32x2*)(H + (size_t)m * D) + lane;
#pragma unroll
        for (int j = 0; j < 4; ++j) { const f32x4 h = v[j] * rstd * ca[j] + cb[j]; u32x2 w; w.x = cvt_pk_bf16(h[0], h[1]); w.y = cvt_pk_bf16(h[2], h[3]); o8[64 * j] = w; }
        if (two) {
            u32x2* o82 = o8 + D / 4;
#pragma unroll
            for (int j = 0; j < 4; ++j) { const f32x4 h = v2[j] * rstd2 * ca[j] + cb[j]; u32x2 w; w.x = cvt_pk_bf16(h[0], h[1]); w.y = cvt_pk_bf16(h[2], h[3]); o82[64 * j] = w; }
        }
    }
}

__device__ __forceinline__ void norm_phase_bf16(const bf16_t* x, const float* ng, const float* mod, bf16_t* Hh) {
    int tidl_ = threadIdx.x; asm volatile("" : "+v"(tidl_));
    const int tid = tidl_, wave = tid >> 6, lane = tid & 63;
    const int gw = blockIdx.x * 8 + wave, NGW = gridDim.x * 8;
    const int R = (T + NGW - 1) / NGW;
    const int m0 = gw * R, m1 = (m0 + R < T) ? m0 + R : T;
    int curb = -1; f32x4 ca[4], cb[4];
    for (int m = m0; m < m1; m += 4) {
        const int b = m / SEQ;
        if (b != curb) { curb = b;
#pragma unroll
            for (int j = 0; j < 4; ++j) { const int col = 8 * lane + 512 * (j >> 1) + 4 * (j & 1);
                const f32x4 g = *(const f32x4*)(ng + col), sc = *(const f32x4*)(mod + b * 3072 + 1024 + col);
                ca[j] = g * (sc + 1.0f); cb[j] = *(const f32x4*)(mod + b * 3072 + col); } }
        u32x4 v[4][2];
#pragma unroll
        for (int r = 0; r < 4; ++r) { const int mr = (m + r < m1) ? m + r : m; const u32x4* xr = (const u32x4*)(x + (size_t)mr * D) + lane; v[r][0] = xr[0]; v[r][1] = xr[64]; }
#pragma unroll
        for (int r = 0; r < 4; ++r) {
            f32x4 f[4];
#pragma unroll
            for (int hh = 0; hh < 2; ++hh) { const u32x4 w = v[r][hh]; f[2 * hh] = (f32x4){bflo(w.x), bfhi(w.x), bflo(w.y), bfhi(w.y)}; f[2 * hh + 1] = (f32x4){bflo(w.z), bfhi(w.z), bflo(w.w), bfhi(w.w)}; }
            float ss = 0.f;
#pragma unroll
            for (int j = 0; j < 4; ++j) ss += (f[j][0] * f[j][0] + f[j][1] * f[j][1]) + (f[j][2] * f[j][2] + f[j][3] * f[j][3]);
            const float rstd = 1.0f / sqrtf(wave_sum(ss) * (1.0f / D) + EPS);
            if (m + r < m1) {
                u32x4* o16 = (u32x4*)(Hh + (size_t)(m + r) * D) + lane;
#pragma unroll
                for (int hh = 0; hh < 2; ++hh) { const f32x4 h0 = f[2 * hh] * rstd * ca[2 * hh] + cb[2 * hh], h1 = f[2 * hh + 1] * rstd * ca[2 * hh + 1] + cb[2 * hh + 1];
                    u32x4 w; w.x = cvt_pk_bf16(h0[0], h0[1]); w.y = cvt_pk_bf16(h0[2], h0[3]); w.z = cvt_pk_bf16(h1[0], h1[1]); w.w = cvt_pk_bf16(h1[2], h1[3]); o16[64 * hh] = w; }
            }
        }
    }
}

__device__ __forceinline__ void attn_unit(LAS unsigned char* lds, const bf16_t* Qm, const bf16_t* Km, const bf16_t* VT, const bf16_t* GBm, bf16_t* YB, int b, int hp, int qb) {
    int tidl_ = threadIdx.x; asm volatile("" : "+v"(tidl_));
    const int tid = tidl_, wave = tid >> 6, lane = tid & 63, fr = lane & 15, fq = lane >> 4;
    const int hsel = wave >> 2, h = 2 * hp + hsel;
    const int q0 = qb * 64, qw = q0 + (hsel ? 3 - (wave & 3) : (wave & 3)) * 16;
    const size_t rowbase = (size_t)b * SEQ;
    LAS unsigned char* KL = lds + hsel * 35840;
    LAS unsigned char* VL = KL + 17408;
    volatile LAS int* FL = (volatile LAS int*)(lds + 71680);
    bf16x8 qf[4];
    { const bf16_t* qp = Qm + (rowbase + qw + fr) * 1024 + h * 128 + fq * 8;
#pragma unroll
      for (int ks = 0; ks < 4; ++ks) qf[ks] = *(const bf16x8*)(qp + ks * 32); }
    f32x4 o[8];
#pragma unroll
    for (int d = 0; d < 8; ++d) o[d] = (f32x4){0.f, 0.f, 0.f, 0.f};
    float Rs = 1.f;
    int kb = q0 >> 6;
    u32x4 pk[4], pv[4];
#define ATT_LOAD(kbi) do { const int k0_ = (kbi) * 64; _Pragma("unroll") for (int i_ = 0; i_ < 4; ++i_) { const int ci = (tid + 512 * i_) & 1023, hh_ = 2 * hp + (i_ >> 1); \
        pk[i_] = *(const u32x4*)(Km + (rowbase + k0_ + (ci >> 4)) * 1024 + hh_ * 128 + (ci & 15) * 8); \
        pv[i_] = *(const u32x4*)(VT + (size_t)(hh_ * 128 + (ci >> 3)) * T + rowbase + k0_ + (ci & 7) * 8); } } while (0)
    ATT_LOAD(kb);
    int it = 0;
    for (;;) {
#pragma unroll
        for (int i = 0; i < 4; ++i) { const int ci = (tid + 512 * i) & 1023; LAS unsigned char* kd = lds + (i >> 1) * 35840;
            *(LAS u32x4*)(kd + (ci >> 4) * 272 + (ci & 15) * 16) = pk[i];
            *(LAS u32x4*)(kd + 17408 + (ci >> 3) * 144 + (ci & 7) * 16) = pv[i]; }
        __syncthreads();
        if (kb > 0) ATT_LOAD(kb - 1);
        const int k0 = kb * 64;
        if (k0 < qw + 15 && !__all(Rs == 0.f)) {
            f32x4 s[4];
#pragma unroll
            for (int rb = 0; rb < 4; ++rb) {
                const int c = rb >> 1, e = rb & 1;
                const int kl = 32 * c + (fr >> 2) * 8 + e * 4 + (fr & 3);
                s[rb] = (f32x4){0.f, 0.f, 0.f, 0.f};
#pragma unroll
                for (int ks = 0; ks < 4; ++ks) {
                    const bf16x8 a = *(const LAS bf16x8*)(KL + kl * 272 + (ks * 32 + fq * 8) * 2);
                    s[rb] = __builtin_amdgcn_mfma_f32_16x16x32_bf16(a, qf[ks], s[rb], 0, 0, 0);
                }
            }
            const int qi = qw + fr;
            float be[2][8], om[2][8];
#pragma unroll
            for (int c = 0; c < 2; ++c)
#pragma unroll
                for (int i = 0; i < 8; ++i) {
                    const float z = s[2 * c + (i >> 2)][i & 3];
                    const int key = k0 + 32 * c + 8 * fq + i;
                    const float e = __builtin_amdgcn_exp2f(-fabsf(z));
                    const float r = __builtin_amdgcn_rcpf(1.0f + e);
                    const bool pos = z >= 0.f, valid = key < qi;
                    be[c][i] = valid ? (pos ? r : e * r) : 0.f;
                    om[c][i] = valid ? (pos ? e * r : r) : 1.f;
                }
            float suf[2][8], Gs[2], Tt[2];
#pragma unroll
            for (int c = 0; c < 2; ++c) {
                float run = 1.f;
#pragma unroll
                for (int i = 7; i >= 0; --i) { suf[c][i] = run; run *= om[c][i]; }
                const float t1 = __shfl(run, (lane + 16) & 63), t2 = __shfl(run, (lane + 32) & 63), t3 = __shfl(run, (lane + 48) & 63);
                Gs[c] = (fq < 3 ? t1 : 1.f) * (fq < 2 ? t2 : 1.f) * (fq < 1 ? t3 : 1.f);
                Tt[c] = (run * t1) * (t2 * t3);
            }
            bf16x8 pf[2];
#pragma unroll
            for (int c = 0; c < 2; ++c) {
                const float basec = Rs * Gs[c] * (c == 0 ? Tt[1] : 1.f);
                float w[8];
#pragma unroll
                for (int i = 0; i < 8; ++i) w[i] = be[c][i] * (suf[c][i] * basec);
                u32x4 pw; pw.x = cvt_pk_bf16(w[0], w[1]); pw.y = cvt_pk_bf16(w[2], w[3]); pw.z = cvt_pk_bf16(w[4], w[5]); pw.w = cvt_pk_bf16(w[6], w[7]);
                pf[c] = __builtin_bit_cast(bf16x8, pw);
            }
            Rs *= Tt[0] * Tt[1];
#pragma unroll
            for (int db = 0; db < 8; ++db)
#pragma unroll
                for (int c = 0; c < 2; ++c) {
                    const bf16x8 a = *(const LAS bf16x8*)(VL + (db * 16 + fr) * 144 + (32 * c + 8 * fq) * 2);
                    o[db] = __builtin_amdgcn_mfma_f32_16x16x32_bf16(a, pf[c], o[db], 0, 0, 0);
                }
        }
        const bool wdone = __all(Rs == 0.f);
        if (lane == 0) FL[(it & 1) * 8 + wave] = wdone ? 1 : 0;
        __syncthreads();
        int alld = 1;
#pragma unroll
        for (int w8 = 0; w8 < 8; ++w8) alld &= FL[(it & 1) * 8 + w8];
        if (alld || kb == 0) break;
        --kb; ++it;
    }
#undef ATT_LOAD
    {
        const size_t off = (rowbase + qw + fr) * 1024 + h * 128 + fq * 4;
#pragma unroll
        for (int db = 0; db < 8; ++db) {
            const u32x2 gw = *(const u32x2*)(GBm + off + db * 16);
            u32x2 w; w.x = cvt_pk_bf16(o[db][0] * bflo(gw.x), o[db][1] * bfhi(gw.x)); w.y = cvt_pk_bf16(o[db][2] * bflo(gw.y), o[db][3] * bfhi(gw.y));
            *(u32x2*)(YB + off + db * 16) = w;
        }
    }
    __syncthreads();
}

template <bool PASSB>
__device__ __forceinline__ void lru_unit(LAS unsigned char* lds, const Params& p, int b, int hd, int chunk) {
    int tidl_ = threadIdx.x; asm volatile("" : "+v"(tidl_));
    const int tid = tidl_, wave = tid >> 6, lane = tid & 63, fr = lane & 15, fq = lane >> 4;
    unsigned char* ws = p.ws;
    const bf16_t* XA = (const bf16_t*)(ws + WS_XA); const bf16_t* GA = (const bf16_t*)(ws + WS_GA); bf16_t* YA = (bf16_t*)(ws + WS_Q);
    const bf16_t* WG = (const bf16_t*)(ws + WS_WG); float* AGG = (float*)(ws + WS_LAGG);
    bf16x8 wf[2][4];
#pragma unroll
    for (int gs = 0; gs < 2; ++gs)
#pragma unroll
        for (int ks = 0; ks < 4; ++ks) wf[gs][ks] = *(const bf16x8*)(WG + ((size_t)hd * 256 + gs * 128 + wave * 16 + fr) * 128 + ks * 32 + fq * 8);
    const int gch = hd * 128 + wave * 16 + fr, chl = wave * 16 + fr;
    const float brv = p.in[9][gch], biv = p.in[11][gch];
    float clv; { const float L = p.in[12][gch]; clv = -8.0f * (fmaxf(-L, 0.f) + log1pf(expf(-fabsf(L)))); }
    const int ch8 = (tid & 15) * 8, tok = tid >> 4;
    float Cst = 0.f, Pacc = 1.f;
    if (PASSB) {
        f32x2 e[LRU_NC];
#pragma unroll
        for (int j = 0; j < LRU_NC - 1; ++j) { const int jj = j < chunk ? j : 0; e[j] = *(const f32x2*)(AGG + ((size_t)(b * LRU_NC + jj) * 1024 + gch) * 2); }
#pragma unroll
        for (int j = 0; j < LRU_NC - 1; ++j) if (j < chunk) Cst = e[j][0] * Cst + e[j][1];
    }
    f32x4 cw0[4], cw1[4];
#pragma unroll
    for (int k = 0; k < 4; ++k) { cw0[k] = *(const f32x4*)(p.in[6] + k * 1024 + hd * 128 + ch8); cw1[k] = *(const f32x4*)(p.in[6] + k * 1024 + hd * 128 + ch8 + 4); }
    const f32x4 cb0 = *(const f32x4*)(p.in[7] + hd * 128 + ch8), cb1 = *(const f32x4*)(p.in[7] + hd * 128 + ch8 + 4);
    u32x4 xw[2][4];
    const bf16_t* xbase = XA + ((size_t)b * SEQ) * 1024 + hd * 128 + ch8;
#define LRU_LOADX(st_) do { const int t0_ = chunk * LRU_LC + (st_) * 64; _Pragma("unroll") for (int i_ = 0; i_ < 2; ++i_) _Pragma("unroll") for (int k_ = 0; k_ < 4; ++k_) { \
        const int ts_ = t0_ + tok + 32 * i_ - 3 + k_; xw[i_][k_] = (ts_ >= 0) ? *(const u32x4*)(xbase + (size_t)ts_ * 1024) : (u32x4){0u, 0u, 0u, 0u}; } } while (0)
    LRU_LOADX(0);
    constexpr int NST = LRU_LC / 64;
    for (int st = 0; st < NST; ++st) {
        const int t0 = chunk * LRU_LC + st * 64;
        LAS unsigned char* XCB = lds + (st & 1) * 51200;
        LAS float* XCF = (LAS float*)(XCB + 17408);
#pragma unroll
        for (int i = 0; i < 2; ++i) {
            const int token = tok + 32 * i;
            f32x4 a0 = cb0, a1 = cb1;
#pragma unroll
            for (int k = 0; k < 4; ++k) {
                const u32x4 x4 = xw[i][k];
                a0[0] += cw0[k][0] * bflo(x4.x); a0[1] += cw0[k][1] * bfhi(x4.x); a0[2] += cw0[k][2] * bflo(x4.y); a0[3] += cw0[k][3] * bfhi(x4.y);
                a1[0] += cw1[k][0] * bflo(x4.z); a1[1] += cw1[k][1] * bfhi(x4.z); a1[2] += cw1[k][2] * bflo(x4.w); a1[3] += cw1[k][3] * bfhi(x4.w);
            }
            u32x4 w; w.x = cvt_pk_bf16(a0[0], a0[1]); w.y = cvt_pk_bf16(a0[2], a0[3]); w.z = cvt_pk_bf16(a1[0], a1[1]); w.w = cvt_pk_bf16(a1[2], a1[3]);
            *(LAS u32x4*)(XCB + (((token >> 2) & 3) * 16 + (token >> 4) * 4 + (token & 3)) * 272 + ch8 * 2) = w;
            *(LAS f32x4*)(XCF + token * 132 + ch8) = a0; *(LAS f32x4*)(XCF + token * 132 + ch8 + 4) = a1;
        }
        __syncthreads();
        if (st + 1 < NST) LRU_LOADX(st + 1);
        const size_t obase = ((size_t)b * SEQ + t0 + fq * 16) * 1024 + hd * 128 + chl;
        unsigned short gvv[16];
        if (PASSB) {
#pragma unroll
            for (int q = 0; q < 16; ++q) gvv[q] = GA[obase + (size_t)q * 1024];
        }
        float hl[16], pl[16];
        float hrun = 0.f, prun = 1.f;
#pragma unroll
        for (int tb = 0; tb < 4; ++tb) {
            f32x4 ar = (f32x4){0.f, 0.f, 0.f, 0.f}, ai = (f32x4){0.f, 0.f, 0.f, 0.f};
#pragma unroll
            for (int ks = 0; ks < 4; ++ks) {
                const bf16x8 a = *(const LAS bf16x8*)(XCB + (tb * 16 + fr) * 272 + (ks * 32 + fq * 8) * 2);
                ar = __builtin_amdgcn_mfma_f32_16x16x32_bf16(a, wf[0][ks], ar, 0, 0, 0);
                ai = __builtin_amdgcn_mfma_f32_16x16x32_bf16(a, wf[1][ks], ai, 0, 0, 0);
            }
#pragma unroll
            for (int j = 0; j < 4; ++j) {
                const int token = fq * 16 + tb * 4 + j;
                const float xcv = XCF[token * 132 + chl];
                const float e1 = __expf(fminf(-(ar[j] + brv), 40.f)), e2 = __expf(fminf(-(ai[j] + biv), 40.f));
                const float inv = __builtin_amdgcn_rcpf((1.0f + e1) * (1.0f + e2));
                const float r = inv * (1.0f + e2), ig = inv * (1.0f + e1);
                const float a = __expf(clv * r);
                const float bb = __builtin_amdgcn_sqrtf(fmaxf(1.0f - a * a, 0.f)) * (ig * xcv);
                hrun = a * hrun + bb; prun *= a;
                if (PASSB) { hl[tb * 4 + j] = hrun; pl[tb * 4 + j] = prun; }
            }
        }
        const float P0 = __shfl(prun, fr), H0 = __shfl(hrun, fr), P1 = __shfl(prun, fr + 16), H1 = __shfl(hrun, fr + 16);
        const float P2 = __shfl(prun, fr + 32), H2 = __shfl(hrun, fr + 32), P3 = __shfl(prun, fr + 48), H3 = __shfl(hrun, fr + 48);
        const float s0 = P0 * Cst + H0, s1 = P1 * s0 + H1, s2 = P2 * s1 + H2, s3 = P3 * s2 + H3;
        const float cin = fq == 0 ? Cst : (fq == 1 ? s0 : (fq == 2 ? s1 : s2));
        Cst = s3;
        if (PASSB) {
#pragma unroll
            for (int q = 0; q < 16; ++q) {
                const float hv = hl[q] + pl[q] * cin;
                const float gt = __uint_as_float(((unsigned)gvv[q]) << 16);
                YA[obase + (size_t)q * 1024] = (bf16_t)(cvt_pk_bf16(hv * gt, 0.f) & 0xffffu);
            }
        } else {
            Pacc *= (P0 * P1) * (P2 * P3);
        }
    }
#undef LRU_LOADX
    if (!PASSB && fq == 0) { *(f32x2*)(AGG + ((size_t)(b * LRU_NC + chunk) * 1024 + gch) * 2) = (f32x2){Pacc, Cst}; }
    __syncthreads();
}

__device__ __forceinline__ void p0_w16(const Params& p) {
    const int idx = blockIdx.x * 512 + threadIdx.x;
    if (idx >= 64 * 64 * 16) return;
    const int g = idx >> 10, pp = (idx >> 4) & 63, sidx = idx & 15, gp = g * 64 + pp;
    const float dt = expf(p.in[19][g]);
    const float lr = p.in[17][gp], li = p.in[18][gp];
    const float x = lr * dt, ang = li * dt;
    float sn, cs; sincosf(ang, &sn, &cs);
    const float em1 = expm1f(x), sh = sinf(0.5f * ang);
    const float nre = em1 * cs - 2.0f * sh * sh, nim = (em1 + 1.0f) * sn;
    const float den = lr * lr + li * li;
    const float cre = (nre * lr + nim * li) / den, cim = (nim * lr - nre * li) / den;
    const float kf = (float)(15 - sidx);
    float sk, ck; sincosf(ang * kf, &sk, &ck);
    const float dk = expf(x * kf), pr = dk * ck, pi = dk * sk;
    const float qr = pr * cre - pi * cim, qi = pr * cim + pi * cre;
    const float* bre = p.in[20] + (size_t)gp * 16; const float* bim = p.in[21] + (size_t)gp * 16;
    unsigned wre[8], wim[8];
#pragma unroll
    for (int c2 = 0; c2 < 8; ++c2) {
        const float br0 = bre[2 * c2], bi0 = bim[2 * c2], br1 = bre[2 * c2 + 1], bi1 = bim[2 * c2 + 1];
        wre[c2] = cvt_pk_bf16(qr * br0 - qi * bi0, qr * br1 - qi * bi1);
        wim[c2] = cvt_pk_bf16(qr * bi0 + qi * br0, qr * bi1 + qi * br1);
    }
    bf16_t* W = (bf16_t*)(p.ws + WS_W16);
    u32x4* o0 = (u32x4*)(W + ((size_t)g * 128 + pp) * 256 + sidx * 16);
    u32x4* o1 = (u32x4*)(W + ((size_t)g * 128 + 64 + pp) * 256 + sidx * 16);
    o0[0] = (u32x4){wre[0], wre[1], wre[2], wre[3]}; o0[1] = (u32x4){wre[4], wre[5], wre[6], wre[7]};
    o1[0] = (u32x4){wim[0], wim[1], wim[2], wim[3]}; o1[1] = (u32x4){wim[4], wim[5], wim[6], wim[7]};
}

__device__ __forceinline__ void s5_passA_mm(LAS unsigned char* lds, const Params& p) {
    int tidl_ = threadIdx.x; asm volatile("" : "+v"(tidl_));
    const int tid = tidl_, wave = tid >> 6, lane = tid & 63, fr = lane & 15, fq = lane >> 4;
    unsigned char* ws = p.ws;
    const bf16_t* U = (const bf16_t*)(ws + WS_XA);
    const bf16_t* W16 = (const bf16_t*)(ws + WS_W16);
    float* AGG = (float*)(ws + WS_SAGG);
    const int nbg = (int)gridDim.x / 64, g = (int)blockIdx.x & 63, sub = (int)blockIdx.x >> 6;
    constexpr int NSUB = S5_LC / 16, NMB = NSUB / 16, NU = NB * S5_NC;
    static_assert(NMB == 2, "s5_passA_mm is written for 512-token chunks");
    LAS unsigned char* wl = lds;
    LAS float* incL = (LAS float*)(lds + 67584 + wave * 8448);
    if (nbg > 0 && sub < nbg) {
        for (int i = tid; i < 128 * 32; i += 512) { const int row = i >> 5, ch = i & 31;
            *(LAS u32x4*)(wl + row * 528 + ch * 16) = *(const u32x4*)(W16 + ((size_t)g * 128 + row) * 256 + ch * 8); }
    }
    __syncthreads();
    if (nbg > 0 && sub < nbg) {
        const f32x2 a16 = *(const f32x2*)((const float*)(ws + WS_AB16) + (g * 64 + lane) * 2);
        for (int uidx = sub * 8 + wave; uidx < NU; uidx += nbg * 8) {
            const int b = uidx / S5_NC, c = uidx % S5_NC;
            const size_t row0 = (size_t)b * SEQ + (size_t)c * S5_LC;
            bf16x8 af[2][8];
#pragma unroll
            for (int mb = 0; mb < 2; ++mb)
#pragma unroll
                for (int ks = 0; ks < 8; ++ks)
                    af[mb][ks] = *(const bf16x8*)(U + ((size_t)g * T + row0 + (size_t)(mb * 16 + fr) * 16 + 2 * ks + (fq >> 1)) * 16 + (fq & 1) * 8);
            float hr = 0.f, hi = 0.f;
#pragma unroll
            for (int mb = 0; mb < 2; ++mb) {
#pragma unroll
                for (int nb = 0; nb < 8; ++nb) {
                    f32x4 d = (f32x4){0.f, 0.f, 0.f, 0.f};
#pragma unroll
                    for (int ks = 0; ks < 8; ++ks) {
                        const bf16x8 bfr = *(const LAS bf16x8*)(wl + (nb * 16 + fr) * 528 + ks * 64 + fq * 16);
                        d = __builtin_amdgcn_mfma_f32_16x16x32_bf16(af[mb][ks], bfr, d, 0, 0, 0);
                    }
#pragma unroll
                    for (int j = 0; j < 4; ++j) incL[(fq * 4 + j) * 132 + nb * 16 + fr] = d[j];
                }
                LDS_WAIT();
#pragma unroll
                for (int j = 0; j < 16; ++j) {
                    const float ir = incL[j * 132 + lane], ii = incL[j * 132 + 64 + lane];
                    const float nr = fmaf(a16[0], hr, fmaf(-a16[1], hi, ir)), ni = fmaf(a16[0], hi, fmaf(a16[1], hr, ii)); hr = nr; hi = ni;
                }
                LDS_WAIT();
            }
            *(f32x2*)(AGG + ((size_t)((b * S5_NC + c) * 64 + g) * 64 + lane) * 2) = (f32x2){hr, hi};
        }
    }
    __syncthreads();
}

template <bool PASSB>
__device__ __forceinline__ void s5_phase(LAS unsigned char* lds, const Params& p) {
    int tidl_ = threadIdx.x; asm volatile("" : "+v"(tidl_));
    const int tid = tidl_, wave = tid >> 6, lane = tid & 63, fr = lane & 15, fq = lane >> 4;
    unsigned char* ws = p.ws;
    const bf16_t* U = (const bf16_t*)(ws + WS_XA); bf16_t* YG = (bf16_t*)(ws + WS_K);
    float* AGG = (float*)(ws + WS_SAGG);
    LAS float* BuL = (LAS float*)(lds + wave * 16384);
    LAS unsigned char* HbL = lds + wave * 16384 + 10240;
    const int gw = blockIdx.x * 8 + wave, NGW = gridDim.x * 8;
    constexpr int NUNIT = NB * S5_NC * 64;
    int curg = -1;
    bf16x8 bfm[8], cfm[4], dfm; float are = 0.f, aim = 0.f, alre = 0.f, alim = 0.f;
    const bf16x8 zero8 = (bf16x8){0, 0, 0, 0, 0, 0, 0, 0};
    for (int un = gw; un < NUNIT; un += NGW) {
        const int g = un & 63, c = (un >> 6) % S5_NC, b = un / (64 * S5_NC);
        if (g != curg) { curg = g;
#pragma unroll
            for (int nb = 0; nb < 8; ++nb) bfm[nb] = (fq < 2) ? *(const bf16x8*)((const bf16_t*)(ws + WS_BBM) + ((size_t)g * 128 + nb * 16 + fr) * 16 + fq * 8) : zero8;
            if (PASSB) {
#pragma unroll
                for (int ks = 0; ks < 4; ++ks) cfm[ks] = *(const bf16x8*)((const bf16_t*)(ws + WS_CM) + ((size_t)g * 16 + fr) * 128 + ks * 32 + fq * 8);
                const unsigned dbits = f2bf(p.in[24][g * 16 + fr]);
                dfm = zero8;
#pragma unroll
                for (int i = 0; i < 8; ++i) if (fq < 2 && fq * 8 + i == fr) dfm[i] = (short)dbits;
            }
            const f32x2 a = *(const f32x2*)((const float*)(ws + WS_ABAR) + (g * 64 + lane) * 2); are = a[0]; aim = a[1];
            const f32x2 al = *(const f32x2*)((const float*)(ws + WS_ABARL) + (g * 64 + lane) * 2); alre = al[0]; alim = al[1];
        }
        float hr = 0.f, hi = 0.f;
        if (PASSB) {
            for (int j0 = 0; j0 < c; j0 += 8) {
                f32x2 e[8];
#pragma unroll
                for (int i = 0; i < 8; ++i) { const int jj = (j0 + i < c) ? j0 + i : c - 1; e[i] = *(const f32x2*)(AGG + ((size_t)((b * S5_NC + jj) * 64 + g) * 64 + lane) * 2); }
#pragma unroll
                for (int i = 0; i < 8; ++i) if (j0 + i < c) { const float nr = alre * hr - alim * hi + e[i][0], ni = alre * hi + alim * hr + e[i][1]; hr = nr; hi = ni; }
            }
        }
        const size_t row0 = (size_t)b * SEQ + (size_t)c * S5_LC;
        const bf16_t* up = U + ((size_t)g * T + row0 + fr) * 16 + (fq & 1) * 8;
        bf16x8 au_q0 = (fq < 2) ? *(const bf16x8*)up : zero8;
        bf16x8 au_q1 = (fq < 2) ? *(const bf16x8*)(up + (size_t)1 * 16 * 16) : zero8;
        bf16x8 au_q2 = (fq < 2) ? *(const bf16x8*)(up + (size_t)2 * 16 * 16) : zero8;
        constexpr int NST = S5_LC / 16;
        for (int st = 0; st < NST; ++st) {
            const size_t r0 = row0 + st * 16;
            const bf16x8 au = au_q0; au_q0 = au_q1; au_q1 = au_q2;
            if (st + 3 < NST) au_q2 = (fq < 2) ? *(const bf16x8*)(up + (size_t)(st + 3) * 16 * 16) : zero8;
#pragma unroll
            for (int nb = 0; nb < 8; ++nb) {
                const f32x4 d = __builtin_amdgcn_mfma_f32_16x16x32_bf16(au, bfm[nb], (f32x4){0.f, 0.f, 0.f, 0.f}, 0, 0, 0);
                *(LAS f32x4*)(BuL + (nb * 16 + fr) * 20 + fq * 4) = d;
            }
            LDS_WAIT();
            f32x4 br4[4], bi4[4];
#pragma unroll
            for (int q = 0; q < 4; ++q) { br4[q] = *(const LAS f32x4*)(BuL + lane * 20 + q * 4); bi4[q] = *(const LAS f32x4*)(BuL + (64 + lane) * 20 + q * 4); }
#pragma unroll
            for (int t = 0; t < 16; ++t) {
                const float bur = br4[t >> 2][t & 3], bui = bi4[t >> 2][t & 3];
                const float nr = are * hr - aim * hi + bur, ni = are * hi + aim * hr + bui; hr = nr; hi = ni;
                if (PASSB) *(LAS unsigned*)(HbL + t * 272 + lane * 4) = cvt_pk_bf16(hr, hi);
            }
            if (PASSB) {
                LDS_WAIT();
                f32x4 y = __builtin_amdgcn_mfma_f32_16x16x32_bf16(au, dfm, (f32x4){0.f, 0.f, 0.f, 0.f}, 0, 0, 0);
#pragma unroll
                for (int ks = 0; ks < 4; ++ks) {
                    const bf16x8 a = *(const LAS bf16x8*)(HbL + fr * 272 + (ks * 32 + fq * 8) * 2);
                    y = __builtin_amdgcn_mfma_f32_16x16x32_bf16(a, cfm[ks], y, 0, 0, 0);
                }
#pragma unroll
                for (int j = 0; j < 4; ++j) {
                    const float v = y[j];
                    const float ge = v * sigmoidf_(1.5957691216057308f * (v + 0.044715f * v * v * v));
                    YG[(r0 + fq * 4 + j) * 1024 + g * 16 + fr] = (bf16_t)(cvt_pk_bf16(ge, ge) & 0xffffu);
                }
            }
            LDS_WAIT();
        }
        if (!PASSB) *(f32x2*)(AGG + ((size_t)((b * S5_NC + c) * 64 + g) * 64 + lane) * 2) = (f32x2){hr, hi};
    }
}


#define XB_TMO      128
#define XB_XCNT(j)  (256  + 64 * (j))
#define XB_XSUB(j)  (1280 + 64 * (j))
#define XB_XGEN(j)  (2304 + 64 * (j))
#define XB_TOP      3328
#define XB_TOPGEN   3392
#define XCD_BAR_WORDS 3456
#define XB_SPIN_CAP (1u << 18)
__device__ __forceinline__ unsigned xb_ld(unsigned* p)              { return __hip_atomic_load(p, __ATOMIC_RELAXED, __HIP_MEMORY_SCOPE_AGENT); }
__device__ __forceinline__ unsigned xb_add(unsigned* p, unsigned v) { return __hip_atomic_fetch_add(p, v, __ATOMIC_RELAXED, __HIP_MEMORY_SCOPE_AGENT); }
__device__ __forceinline__ unsigned xb_xcc_id() { return (unsigned)__builtin_amdgcn_s_getreg((3 << 11) | 20) & 0xFu; }
#define XB_SPIN(cond, bar) do { unsigned _sp = 0; while (cond) { __builtin_amdgcn_s_sleep(1); \
    if ((++_sp & 255u) == 0u) { if (xb_ld(&(bar)[XB_TMO])) break; if (_sp > XB_SPIN_CAP) { atomicAdd(&(bar)[XB_TMO], 1u); break; } } } } while (0)
struct XcdBarrier { unsigned* bar; unsigned x; volatile LAS unsigned* st; };
__device__ __forceinline__ XcdBarrier xcd_barrier_post(unsigned* bar, volatile LAS unsigned* st) {
    XcdBarrier b; b.bar = bar; b.x = xb_xcc_id(); b.st = st;
    if (threadIdx.x == 0) (void)xb_add(&bar[XB_XCNT(b.x)], 1u);
    return b;
}
__device__ __forceinline__ void xcd_barrier_complete(unsigned* bar, unsigned x, unsigned& nloc, unsigned& nx) {
    const unsigned G = gridDim.x * gridDim.y * gridDim.z;
    unsigned sum, cnt, mine, sp = 0u;
    for (;;) {
        sum = 0u; cnt = 0u; mine = 0u;
#pragma unroll
        for (unsigned j = 0; j < 16; ++j) { const unsigned c = xb_ld(&bar[XB_XCNT(j)]); sum += c; cnt += (c > 0u) ? 1u : 0u; mine = (j == x) ? c : mine; }
        if (sum == G) break;
        __builtin_amdgcn_s_sleep(1);
        if ((++sp & 255u) == 0u) { if (xb_ld(&bar[XB_TMO])) break; if (sp > XB_SPIN_CAP) { atomicAdd(&bar[XB_TMO], 1u); break; } }
    }
    nloc = mine > 0u ? mine : 1u; nx = cnt > 0u ? cnt : 1u;
}
__device__ __forceinline__ void xcd_barrier(const XcdBarrier& b) {
    asm volatile("s_waitcnt vmcnt(0)" ::: "memory");
    __syncthreads();
    if (threadIdx.x == 0) {
        unsigned* bar = b.bar;
        const unsigned bx = xb_xcc_id();
        __builtin_amdgcn_s_waitcnt(0);
        unsigned nloc = b.st[0], nx = b.st[1];
        if (nloc == 0u) { xcd_barrier_complete(bar, bx, nloc, nx); b.st[0] = nloc; b.st[1] = nx; }
        const unsigned old = xb_add(&bar[XB_XSUB(bx)], 1u);
        const unsigned gen = old / nloc;
        if (old + 1u == (gen + 1u) * nloc) {
            __builtin_amdgcn_fence(__ATOMIC_RELEASE, "agent");
            asm volatile("s_waitcnt vmcnt(0)" ::: "memory");
            const unsigned og = xb_add(&bar[XB_TOP], 1u);
            const unsigned tg = og / nx;
            if (og + 1u == (tg + 1u) * nx) xb_add(&bar[XB_TOPGEN], 1u);
            else XB_SPIN(xb_ld(&bar[XB_TOPGEN]) == tg, bar);
            __builtin_amdgcn_fence(__ATOMIC_ACQUIRE, "agent");
            xb_add(&bar[XB_XGEN(bx)], 1u);
            asm volatile("s_waitcnt vmcnt(0)" ::: "memory");
        } else {
            XB_SPIN(xb_ld(&bar[XB_XGEN(bx)]) == gen, bar);
            __builtin_amdgcn_fence(__ATOMIC_ACQUIRE, "agent");
            asm volatile("s_waitcnt vmcnt(0)" ::: "memory");
        }
    }
    __syncthreads();
}

#define PP p
__global__ void __launch_bounds__(512, 2) fwd_megakernel(Params p) {
    extern __shared__ __attribute__((aligned(16))) unsigned char lds_raw[];
    LAS unsigned char* lds = (LAS unsigned char*)lds_raw;
    cg::grid_group grid = cg::this_grid();
    unsigned char* ws = PP.ws;
    const int G = gridDim.x;
    float* MOD = (float*)(ws + WS_MOD);
    bf16_t* H = (bf16_t*)(ws + WS_H); bf16_t* XA = (bf16_t*)(ws + WS_XA); bf16_t* GA = (bf16_t*)(ws + WS_GA);
    bf16_t* Qb = (bf16_t*)(ws + WS_Q); bf16_t* Kb = (bf16_t*)(ws + WS_K); bf16_t* VT = (bf16_t*)(ws + WS_VT); bf16_t* GB = (bf16_t*)(ws + WS_GB);

    if (threadIdx.x < 16) ((LAS unsigned*)(lds + BARST_OFF))[threadIdx.x] = 0u;
    __syncthreads();
    (void)xcd_barrier_post((unsigned*)ws, (volatile LAS unsigned*)(lds + BARST_OFF));
#define GSYNC() do { XcdBarrier xb_; xb_.bar = (unsigned*)PP.ws; xb_.x = 0; xb_.st = (volatile LAS unsigned*)(lds + BARST_OFF); xcd_barrier(xb_); } while (0)
    p0_prologue(PP, lds);
    p0_weights(PP, lds);
    p0_w16(PP);
    if (PP.ws == nullptr) grid.sync();
    GSYNC();
    norm_phase(PP.in[0], PP.in[2], MOD, H);
    GSYNC();
    for (int rep = 0; rep < REP_GALL; ++rep) {
        pg8::Gemm g{H, H, (const bf16_t*)(ws + WS_WINE), T, 5120, 1024, 1024, 16};
        pg8::StaticOrder S; S.init(T, 5120, G, (int)blockIdx.x);
        pg8::EpiInE E{XA, GA, Qb, Kb, GB, PP.in[13], PP.in[14]};
        pg8::gemm_phase<pg8::EpiInE>(lds, g, S, E);
        const bf16_t* Wv = (const bf16_t*)(ws + WS_WINE) + (size_t)5120 * 1024;
        pg8::Gemm g2{Wv, Wv, H, 1024, T, 1024, 1024, 16};
        pg8::StaticOrder S2; S2.init(1024, T, G, (int)blockIdx.x);
        pg8::EpiSeg E2{VT, nullptr, T, 0};
        pg8::gemm_phase<pg8::EpiSeg>(lds, g2, S2, E2);
    }
    GSYNC();
    {
        for (int rep = 0; rep < REP_LRU; ++rep)
        for (int un = blockIdx.x; un < NB * 8 * LRU_NC; un += G) { const int chunk = un % LRU_NC, hd = (un / LRU_NC) & 7, b = un / (LRU_NC * 8); lru_unit<false>(lds, PP, b, hd, chunk); }
        for (int rep = 0; rep < REP_ATT; ++rep)
        for (int un = blockIdx.x; un < NB * 4 * 128; un += G) { const int bh = un & 15, qb = 127 - (un >> 4); attn_unit(lds, Qb, Kb, VT, GB, H, bh >> 2, bh & 3, qb); }
    }
    GSYNC();
    for (int rep = 0; rep < REP_LRU; ++rep) {
    for (int un = blockIdx.x; un < NB * 8 * LRU_NC; un += G) { const int chunk = un % LRU_NC, hd = (un / LRU_NC) & 7, b = un / (LRU_NC * 8); lru_unit<true>(lds, PP, b, hd, chunk); }
    GSYNC(); }
    for (int rep = 0; rep < REP_GALL; ++rep) {
        pg8::Gemm g{Qb, H, (const bf16_t*)(ws + WS_WOUTE), T, 1024, 2048, 1024, 16};
        pg8::StaticOrder S; S.init(T, 1024, G, (int)blockIdx.x);
        pg8::EpiResA E{PP.in[0], GB, MOD + 2048};
        pg8::gemm_phase<pg8::EpiResA>(lds, g, S, E);
    }
    GSYNC();
    for (int rep = 0; rep < REP_NORM; ++rep) { norm_phase_bf16(GB, PP.in[2] + 1024, MOD + 4 * 3072, H);
    GSYNC(); }
    for (int rep = 0; rep < REP_G7; ++rep) {
        pg8::Gemm g{H, H, (const bf16_t*)(ws + WS_WINO), T, 2048, 1024, 1024, 16};
        pg8::StaticOrder S; S.init(T, 2048, G, (int)blockIdx.x);
        pg8::EpiSeg E{XA, GA, 1024, 3};
        pg8::gemm_phase<pg8::EpiSeg>(lds, g, S, E);
    }
    GSYNC();
    for (int rep = 0; rep < REP_S5; ++rep) { s5_passA_mm(lds, PP);
    GSYNC(); }
    for (int rep = 0; rep < REP_S5; ++rep) { s5_phase<true>(lds, PP);
    GSYNC(); }
    for (int rep = 0; rep < REP_GALL; ++rep) {
        pg8::Gemm g{Kb, Kb, (const bf16_t*)(ws + WS_WGLU), T, 1024, 1024, 1024, 16};
        pg8::StaticOrder S; S.init(T, 1024, G, (int)blockIdx.x);
        pg8::EpiGlu E{Kb, GA, VT, PP.in[26]};
        pg8::gemm_phase<pg8::EpiGlu>(lds, g, S, E);
    }
    GSYNC();
    {
        pg8::Gemm g{VT, VT, (const bf16_t*)(ws + WS_WOUTO), T, 1024, 1024, 1024, 16};
        pg8::StaticOrder S; S.init(T, 1024, G, (int)blockIdx.x);
        pg8::EpiResB E{GB, PP.out, MOD + 4 * 3072 + 2048};
        pg8::gemm_phase<pg8::EpiResB>(lds, g, S, E);
    }
}

#undef PP
extern "C" void kernel_launch(void* const* d_in, const int* in_sizes, int n_in, void* d_out, int out_size, void* d_ws, size_t ws_size, hipStream_t stream) {
    static int grid_blocks = 0;
    if (grid_blocks == 0) {
        if (n_in != 28 || out_size != T * D || ws_size < WS_END) { fprintf(stderr, "kernel_launch: unexpected shapes (n_in %d out %d ws %zu)\n", n_in, out_size, ws_size); grid_blocks = -1; return; }
        int dev = 0, cus = 0, per_cu = 0;
        hipGetDevice(&dev);
        hipDeviceGetAttribute(&cus, hipDeviceAttributeMultiprocessorCount, dev);
        if (hipFuncSetAttribute((const void*)fwd_megakernel, hipFuncAttributeMaxDynamicSharedMemorySize, LDS_BYTES) != hipSuccess) { fprintf(stderr, "kernel_launch: hipFuncSetAttribute failed\n"); grid_blocks = -1; return; }
        if (hipOccupancyMaxActiveBlocksPerMultiprocessor(&per_cu, (const void*)fwd_megakernel, 512, LDS_BYTES) != hipSuccess || per_cu < 1) { per_cu = 1; (void)hipGetLastError(); }
        grid_blocks = cus * per_cu;
    }
    if (grid_blocks < 0) return;
    if (hipMemsetAsync(d_ws, 0, 16384, stream) != hipSuccess) { fprintf(stderr, "kernel_launch: memset failed\n"); return; }
    Params p{};
    for (int i = 0; i < 28; ++i) p.in[i] = (const float*)d_in[i];
    p.out = (float*)d_out; p.ws = (unsigned char*)d_ws;
    void* args[] = {&p};
    hipError_t e = hipLaunchCooperativeKernel((const void*)fwd_megakernel, dim3(grid_blocks), dim3(512), args, LDS_BYTES, stream);
    if (e != hipSuccess) fprintf(stderr, "cooperative launch failed: %s (grid %d)\n", hipGetErrorString(e), grid_blocks);
}
```

```cpp
#include <hip/hip_runtime.h>
#include <hip/hip_cooperative_groups.h>
#include <cstdio>
#include <cstdint>
namespace cg = cooperative_groups;

#define LAS __attribute__((address_space(3)))
typedef unsigned short bf16_t;
typedef short bf16x8 __attribute__((ext_vector_type(8)));
typedef float f32x4 __attribute__((ext_vector_type(4)));
typedef float f32x2 __attribute__((ext_vector_type(2)));
typedef unsigned u32x4 __attribute__((ext_vector_type(4)));
typedef unsigned u32x2 __attribute__((ext_vector_type(2)));

constexpr int SEQ = 8192, NB = 4, T = NB * SEQ, D = 1024;
constexpr float EPS = 1e-6f;
constexpr float QSCALE = 0.08838834764831845f * 1.4426950408889634f;
#ifndef REP_LRU
#define REP_LRU 1
#endif
#ifndef REP_ATT
#define REP_ATT 1
#endif
#ifndef REP_S5
#define REP_S5 1
#endif
#ifndef REP_G7
#define REP_G7 1
#endif
#ifndef REP_GALL
#define REP_GALL 1
#endif
#ifndef REP_NORM
#define REP_NORM 1
#endif
constexpr int LRU_NC = 8, LRU_LC = SEQ / LRU_NC;
constexpr int S5_LC = 512, S5_NC = SEQ / S5_LC;

constexpr size_t MiB = 1u << 20;
constexpr size_t WS_MOD = 1 * MiB;
constexpr size_t WS_ABAR = WS_MOD + 128 * 1024;
constexpr size_t WS_ABARL = WS_ABAR + 32 * 1024;
constexpr size_t WS_BBM = WS_ABARL + 32 * 1024;
constexpr size_t WS_CM = WS_BBM + 256 * 1024;
constexpr size_t WS_AB16 = 1 * MiB + 768 * 1024;
constexpr size_t WS_WG = 2 * MiB;
constexpr size_t WS_LAGG = WS_WG + 512 * 1024;
constexpr size_t WS_SAGG = 4 * MiB;
constexpr size_t WS_WINE = 8 * MiB;
constexpr size_t WS_WOUTE = 20 * MiB;
constexpr size_t WS_WINO = 24 * MiB;
constexpr size_t WS_WGLU = 28 * MiB;
constexpr size_t WS_WOUTO = 30 * MiB;
constexpr size_t WS_H = 32 * MiB;
constexpr size_t WS_XA = 96 * MiB;
constexpr size_t WS_GA = 160 * MiB;
constexpr size_t WS_Q = 224 * MiB;
constexpr size_t WS_K = 288 * MiB;
constexpr size_t WS_VT = 352 * MiB;
constexpr size_t WS_GB = 416 * MiB;
constexpr size_t WS_W16 = 480 * MiB;
constexpr size_t WS_END = 484 * MiB;

constexpr int XCH_OFF = 131072;
constexpr int BARST_OFF = XCH_OFF + 8192;
constexpr int LDS_BYTES = 147456;

__device__ __forceinline__ unsigned cvt_pk_bf16(float lo, float hi) { unsigned r; asm volatile("v_cvt_pk_bf16_f32 %0, %1, %2" : "=v"(r) : "v"(lo), "v"(hi)); return r; }
__device__ __forceinline__ unsigned f2bf(float f) { unsigned u = __float_as_uint(f); return (u + 0x7fffu + ((u >> 16) & 1u)) >> 16; }
__device__ __forceinline__ float bflo(unsigned w) { return __uint_as_float(w << 16); }
__device__ __forceinline__ float bfhi(unsigned w) { return __uint_as_float(w & 0xffff0000u); }
__device__ __forceinline__ float sigmoidf_(float x) { return __builtin_amdgcn_rcpf(1.0f + __expf(-x)); }
__device__ __forceinline__ float siluf_(float x) { return x * sigmoidf_(x); }
__device__ __forceinline__ float wave_sum(float v) {
#pragma unroll
    for (int o = 1; o < 64; o <<= 1) v += __shfl_xor(v, o);
    return v;
}
#define LDS_WAIT() asm volatile("s_waitcnt lgkmcnt(0)" ::: "memory")

struct Params { const float* in[28]; float* out; unsigned char* ws; };

namespace pg8 {
constexpr int BM = 256, BK = 64, HALF = 128, HTB = HALF * BK * 2, NXCD = 8, WGM = 8;
__device__ __forceinline__ int lds_byte(int r, int c) { const int st = (r >> 4) * 2 + (c >> 5), rr = r & 15, cc = c & 31, ob = rr * 64 + cc * 2; return st * 1024 + (ob ^ (((ob >> 9) & 1) << 5)); }
__device__ __forceinline__ void stage_rc(int b, int& R, int& C) { const int st = b / 1024, sb = b % 1024, swz = sb ^ (((sb >> 9) & 1) << 5); R = (st >> 1) * 16 + swz / 64; C = (st & 1) * 32 + (swz % 64) / 2; }
__device__ __forceinline__ int perm32(int rho) { const int n = rho >> 4, i = rho & 15; return 8 * (i >> 2) + 4 * n + (i & 3); }
struct Unit { int pm, pn; };
struct Gemm { const bf16_t* A; const bf16_t* A2; const bf16_t* Bt; int M, N, K, lda, ks; };
struct StaticOrder {
    int nM, nN, nwg, G, c;
    __device__ void init(int M, int N, int G_, int c_) { nM = M / BM; nN = N / BM; nwg = nM * nN; G = G_; c = c_; }
    __device__ bool next(int i, Unit& u) const {
        const long L = (long)i * G + c; if (L >= nwg) return false;
        int wgid = (int)L; { const int q = nwg / NXCD, r = nwg % NXCD, xcd = wgid % NXCD, off = wgid / NXCD; wgid = (xcd < r ? xcd * (q + 1) : r * (q + 1) + (xcd - r) * q) + off; }
        const int nig = WGM * nN, gid = wgid / nig, fm = gid * WGM, gsz = (nM - fm) < WGM ? (nM - fm) : WGM;
        u.pm = fm + ((wgid % nig) % gsz); u.pn = (wgid % nig) / gsz; return true;
    }
};

template <class Epi, bool ALIGN_EPI = true, bool SP2 = true>
__device__ __forceinline__ void gemm_phase(LAS unsigned char* lds, const Gemm g, const StaticOrder& S, const Epi& E) {
    int tid_ = threadIdx.x; asm volatile("" : "+v"(tid_));
    const int tid = tid_, wid = __builtin_amdgcn_readfirstlane(tid >> 6), lane = tid & 63, wr = wid >> 2, wc = wid & 3, fr = lane & 15, fq = lane >> 4;
    const int K = g.K, nt = K / BK;
    unsigned voffA[2], voffB[2];
#pragma unroll
    for (int i = 0; i < 2; ++i) { int R, C; stage_rc(tid * 16 + i * 8192, R, C); const int Rb = Epi::PERM ? ((R & ~31) + perm32(R & 31)) : R;
        voffA[i] = (unsigned)(R * g.lda + C) * 2u; voffB[i] = (unsigned)(Rb * K + C) * 2u; }
    const size_t kstep = (size_t)(BK * 2);
    const size_t hstepA = (size_t)HALF * g.lda * 2, hstepB = (size_t)HALF * K * 2;
    const size_t tstepA = 2 * hstepA, tstepB = 2 * hstepB;
    const unsigned ldsw = (unsigned)wid * 1024u;
    const int aoff = lds_byte(wr * 64 + fr, fq * 8), boff = lds_byte(wc * 32 + fr, fq * 8);
#define PG8_ATILE(pm, t) (((t) < g.ks ? (const char*)g.A + (size_t)(t) * kstep : (const char*)g.A2 + (size_t)((t) - g.ks) * kstep) + (size_t)(pm) * tstepA)
#define PG8_SA(b, h) (((b) * 2 + (h)) * HTB)
#define PG8_SB(b, h) ((4 + (b) * 2 + (h)) * HTB)
#define PG8_STAGE(bufoff, gbase, voff) do { _Pragma("unroll") for (int _i = 0; _i < 2; ++_i) \
        __builtin_amdgcn_global_load_lds((const unsigned*)((const char*)(gbase) + (voff)[_i]), (LAS unsigned*)(lds + (bufoff) + ldsw + _i * 8192), 16, 0, 0); } while (0)
#define PG8_LDA(dst, b, h) do { _Pragma("unroll") for (int m = 0; m < 4; ++m) _Pragma("unroll") for (int k = 0; k < 2; ++k) dst[m][k] = *(const LAS bf16x8*)(lds + PG8_SA(b, h) + aoff + m * 2048 + k * 1024); } while (0)
#define PG8_LDB(dst, b, h) do { _Pragma("unroll") for (int n = 0; n < 2; ++n) _Pragma("unroll") for (int k = 0; k < 2; ++k) dst[n][k] = *(const LAS bf16x8*)(lds + PG8_SB(b, h) + boff + n * 2048 + k * 1024); } while (0)
#define PG8_MMA(ai, bj, At, Bt) do { __builtin_amdgcn_s_setprio(1); _Pragma("unroll") for (int m = 0; m < 4; ++m) _Pragma("unroll") for (int n = 0; n < 2; ++n) _Pragma("unroll") for (int k = 0; k < 2; ++k) \
        acc[ai][bj][m][n] = __builtin_amdgcn_mfma_f32_16x16x32_bf16(Bt[n][k], At[m][k], acc[ai][bj][m][n], 0, 0, 0); __builtin_amdgcn_s_setprio(0); } while (0)
#define PG8_WAIT_V(n) asm volatile("s_waitcnt vmcnt(" #n ")" ::: "memory")
#define PG8_WAIT_L(n) asm volatile("s_waitcnt lgkmcnt(" #n ")" ::: "memory")
#define PG8_BAR __builtin_amdgcn_s_barrier()
#define PG8_SCHED __builtin_amdgcn_sched_barrier(0)
    Unit cur, nxt; int ui = 0;
    if (!S.next(0, cur)) return;
    f32x4 acc[2][2][4][2];
#pragma unroll
    for (int a = 0; a < 2; ++a)
#pragma unroll
        for (int b = 0; b < 2; ++b)
#pragma unroll
            for (int m = 0; m < 4; ++m)
#pragma unroll
                for (int n = 0; n < 2; ++n) acc[a][b][m][n] = (f32x4){0.f, 0.f, 0.f, 0.f};
    bf16x8 At[4][2], B0[2][2], B1[2][2];
    const char* cB = (const char*)g.Bt + (size_t)cur.pn * tstepB;
    {
        const char* cA0 = PG8_ATILE(cur.pm, 0); const char* cA1 = PG8_ATILE(cur.pm, 1);
        if constexpr (SP2) {
            PG8_STAGE(PG8_SB(0, 0), cB, voffB); PG8_STAGE(PG8_SB(0, 1), cB + hstepB, voffB); PG8_STAGE(PG8_SA(0, 0), cA0, voffA); PG8_STAGE(PG8_SA(0, 1), cA0 + hstepA, voffA);
            if (wr == 1) PG8_BAR;
            PG8_WAIT_V(2); PG8_BAR;
            PG8_STAGE(PG8_SB(1, 0), cB + kstep, voffB); PG8_STAGE(PG8_SA(1, 0), cA1, voffA); PG8_STAGE(PG8_SB(1, 1), cB + hstepB + kstep, voffB);
            PG8_WAIT_V(6); PG8_BAR;
        } else {
            PG8_STAGE(PG8_SB(0, 0), cB, voffB); PG8_STAGE(PG8_SA(0, 0), cA0, voffA); PG8_STAGE(PG8_SB(0, 1), cB + hstepB, voffB); PG8_STAGE(PG8_SA(0, 1), cA0 + hstepA, voffA);
            if (wr == 1) PG8_BAR;
            PG8_WAIT_V(4); PG8_BAR;
            PG8_STAGE(PG8_SB(1, 0), cB + kstep, voffB); PG8_STAGE(PG8_SA(1, 0), cA1, voffA); PG8_STAGE(PG8_SB(1, 1), cB + hstepB + kstep, voffB);
            PG8_WAIT_V(6); PG8_BAR;
        }
    }
    for (;;) {
        const bool has_next = S.next(ui + 1, nxt);
        const int npm = has_next ? nxt.pm : cur.pm;
        const char* nB = has_next ? (const char*)g.Bt + (size_t)nxt.pn * tstepB : cB;
        for (int t = 0; t < nt; t += 2) {
            const bool last = (t == nt - 2);
            const char* a1 = PG8_ATILE(cur.pm, t + 1);
            const char* a2 = last ? PG8_ATILE(npm, 0) : PG8_ATILE(cur.pm, t + 2);
            const char* a3 = last ? PG8_ATILE(npm, 1) : PG8_ATILE(cur.pm, t + 3);
            const char* b2 = last ? nB : cB + (size_t)(t + 2) * kstep;
            const char* b3 = b2 + kstep;
            if constexpr (SP2) {
            PG8_LDB(B0, 0, 0); PG8_LDB(B1, 0, 1); PG8_SCHED; PG8_LDA(At, 0, 0); PG8_STAGE(PG8_SA(1, 1), a1 + hstepA, voffA);
            PG8_WAIT_V(8); PG8_WAIT_L(0); PG8_BAR; PG8_MMA(0, 0, At, B0); PG8_MMA(0, 1, At, B1); PG8_BAR; PG8_SCHED;
            PG8_LDA(At, 0, 1); PG8_STAGE(PG8_SB(0, 0), b2, voffB); PG8_STAGE(PG8_SB(0, 1), b2 + hstepB, voffB); PG8_STAGE(PG8_SA(0, 0), a2, voffA);
            PG8_WAIT_V(8); PG8_WAIT_L(0); PG8_BAR; PG8_MMA(1, 0, At, B0); PG8_MMA(1, 1, At, B1); PG8_BAR; PG8_SCHED;
            PG8_LDB(B0, 1, 0); PG8_LDB(B1, 1, 1); PG8_SCHED; PG8_LDA(At, 1, 0); PG8_STAGE(PG8_SA(0, 1), a2 + hstepA, voffA);
            PG8_WAIT_V(8); PG8_WAIT_L(0); PG8_BAR; PG8_MMA(0, 0, At, B0); PG8_MMA(0, 1, At, B1); PG8_BAR; PG8_SCHED;
            PG8_LDA(At, 1, 1); PG8_STAGE(PG8_SB(1, 0), b3, voffB); PG8_STAGE(PG8_SB(1, 1), b3 + hstepB, voffB); PG8_STAGE(PG8_SA(1, 0), a3, voffA);
            PG8_WAIT_V(8); PG8_WAIT_L(0); PG8_BAR; PG8_MMA(1, 0, At, B0); PG8_MMA(1, 1, At, B1); PG8_BAR; PG8_SCHED;
            } else {
            PG8_LDB(B0, 0, 0); PG8_SCHED; PG8_LDA(At, 0, 0); PG8_STAGE(PG8_SA(1, 1), a1 + hstepA, voffA);
            PG8_WAIT_L(8); PG8_BAR; PG8_WAIT_L(0); PG8_MMA(0, 0, At, B0); PG8_BAR; PG8_SCHED;
            PG8_LDB(B1, 0, 1); PG8_STAGE(PG8_SB(0, 0), b2, voffB);
            PG8_BAR; PG8_WAIT_L(0); PG8_MMA(0, 1, At, B1); PG8_BAR;
            PG8_LDA(At, 0, 1); PG8_STAGE(PG8_SA(0, 0), a2, voffA);
            PG8_BAR; PG8_WAIT_L(0); PG8_MMA(1, 0, At, B0); PG8_BAR; PG8_SCHED;
            PG8_STAGE(PG8_SB(0, 1), b2 + hstepB, voffB);
            PG8_WAIT_V(6); PG8_BAR; PG8_MMA(1, 1, At, B1); PG8_BAR;
            PG8_LDB(B0, 1, 0); PG8_SCHED; PG8_LDA(At, 1, 0); PG8_STAGE(PG8_SA(0, 1), a2 + hstepA, voffA);
            PG8_WAIT_L(8); PG8_BAR; PG8_WAIT_L(0); PG8_MMA(0, 0, At, B0); PG8_BAR; PG8_SCHED;
            PG8_LDB(B1, 1, 1); PG8_STAGE(PG8_SB(1, 0), b3, voffB);
            PG8_BAR; PG8_WAIT_L(0); PG8_MMA(0, 1, At, B1); PG8_BAR;
            PG8_LDA(At, 1, 1); PG8_STAGE(PG8_SA(1, 0), a3, voffA);
            PG8_BAR; PG8_WAIT_L(0); PG8_MMA(1, 0, At, B0); PG8_BAR; PG8_SCHED;
            PG8_STAGE(PG8_SB(1, 1), b3 + hstepB, voffB);
            PG8_WAIT_V(6); PG8_BAR; PG8_MMA(1, 1, At, B1); PG8_BAR;
                    }
        }
        if constexpr (ALIGN_EPI) { if (wr == 0) PG8_BAR; }
        E(acc, cur, wr, wc, fr, fq, lds);
        if (!has_next) break;
#pragma unroll
        for (int a = 0; a < 2; ++a)
#pragma unroll
            for (int b = 0; b < 2; ++b)
#pragma unroll
                for (int m = 0; m < 4; ++m)
#pragma unroll
                    for (int n = 0; n < 2; ++n) acc[a][b][m][n] = (f32x4){0.f, 0.f, 0.f, 0.f};
        cur = nxt; cB = nB; ++ui;
        if constexpr (ALIGN_EPI) { if (wr == 1) PG8_BAR; }
    }
    PG8_WAIT_V(0);
    if constexpr (!ALIGN_EPI) { if (wr == 0) PG8_BAR; }
    PG8_BAR;
#undef PG8_ATILE
#undef PG8_SA
#undef PG8_SB
#undef PG8_STAGE
#undef PG8_LDA
#undef PG8_LDB
#undef PG8_MMA
#undef PG8_WAIT_V
#undef PG8_WAIT_L
#undef PG8_BAR
#undef PG8_SCHED
}

__device__ __forceinline__ void store8(bf16_t* p, const f32x4 v0, const f32x4 v1) {
    u32x4 w; w.x = cvt_pk_bf16(v0[0], v0[1]); w.y = cvt_pk_bf16(v0[2], v0[3]); w.z = cvt_pk_bf16(v1[0], v1[1]); w.w = cvt_pk_bf16(v1[2], v1[3]);
    *(u32x4*)p = w;
}
struct EpiInE {
    static constexpr bool PERM = true;
    bf16_t *XA, *GA, *Q, *K, *GB; const float *qg, *kg;
    __device__ __forceinline__ void operator()(f32x4 (&acc)[2][2][4][2], const Unit& u, int wr, int wc, int fr, int fq, LAS unsigned char* lds) const {
        const int seg = u.pn >> 2, colt = (u.pn & 3) * 256;
        const int row0 = u.pm * BM + wr * 64 + fr;
        const int col0 = colt + wc * 32 + 8 * fq;
        bf16_t* base = seg == 0 ? XA : seg == 1 ? GA : seg == 2 ? Q : seg == 3 ? K : GB;
        if (seg == 2 || seg == 3) {
            LAS float* X = (LAS float*)(lds + XCH_OFF);
#pragma unroll
            for (int ai = 0; ai < 2; ++ai)
#pragma unroll
                for (int m = 0; m < 4; ++m)
#pragma unroll
                    for (int bj = 0; bj < 2; ++bj) {
                        const f32x4 a = acc[ai][bj][m][0], b = acc[ai][bj][m][1];
                        float s = (a[0] * a[0] + a[1] * a[1]) + (a[2] * a[2] + a[3] * a[3]) + (b[0] * b[0] + b[1] * b[1]) + (b[2] * b[2] + b[3] * b[3]);
                        s += __shfl_xor(s, 16); s += __shfl_xor(s, 32);
                        if (fq == 0) X[((wr * 2 + bj) * 128 + ai * 64 + m * 16 + fr) * 4 + wc] = s;
                    }
            asm volatile("s_waitcnt lgkmcnt(0)" ::: "memory"); __builtin_amdgcn_s_barrier(); asm volatile("" ::: "memory");
            const float* gv = (seg == 2) ? qg : kg; const float sc = (seg == 2) ? QSCALE : 1.0f;
            const int hc = wc * 32 + 8 * fq;
            f32x4 g0 = *(const f32x4*)(gv + hc), g1 = *(const f32x4*)(gv + hc + 4);
            g0 = g0 * sc; g1 = g1 * sc;
#pragma unroll
            for (int ai = 0; ai < 2; ++ai)
#pragma unroll
                for (int m = 0; m < 4; ++m) {
                    bf16_t* rowp = base + (size_t)(row0 + ai * HALF + m * 16) * 1024 + col0;
#pragma unroll
                    for (int bj = 0; bj < 2; ++bj) {
                        const f32x4 t = *(const LAS f32x4*)(X + ((wr * 2 + bj) * 128 + ai * 64 + m * 16 + fr) * 4);
                        const float rstd = __builtin_amdgcn_rsqf(((t[0] + t[1]) + (t[2] + t[3])) * (1.0f / 128.0f) + EPS);
                        store8(rowp + bj * HALF, acc[ai][bj][m][0] * rstd * g0, acc[ai][bj][m][1] * rstd * g1);
                    }
                }
        } else {
            const bool act = (seg == 1 || seg == 4);
#pragma unroll
            for (int ai = 0; ai < 2; ++ai)
#pragma unroll
                for (int m = 0; m < 4; ++m) {
                    bf16_t* rowp = base + (size_t)(row0 + ai * HALF + m * 16) * 1024 + col0;
#pragma unroll
                    for (int bj = 0; bj < 2; ++bj) {
                        f32x4 v0 = acc[ai][bj][m][0], v1 = acc[ai][bj][m][1];
                        if (act) {
#pragma unroll
                            for (int j = 0; j < 4; ++j) { v0[j] = siluf_(v0[j]); v1[j] = siluf_(v1[j]); }
                        }
                        store8(rowp + bj * HALF, v0, v1);
                    }
                }
        }
    }
};
struct EpiSeg {
    static constexpr bool PERM = true;
    bf16_t* O0; bf16_t* O1; int ldc; int act1;
    __device__ __forceinline__ void operator()(f32x4 (&acc)[2][2][4][2], const Unit& u, int wr, int wc, int fr, int fq, LAS unsigned char* lds) const {
        const int seg = (u.pn * BM) / ldc >= 1 && O1 != nullptr ? 1 : 0;
        const int colt = (O1 != nullptr) ? (u.pn * BM - seg * ldc) : u.pn * BM;
        bf16_t* base = seg ? O1 : O0;
        const bool act = seg && (act1 & 1);
        const bool grp = !seg && (act1 & 2);
        const int row0 = u.pm * BM + wr * 64 + fr, col0 = colt + wc * 32 + 8 * fq;
#pragma unroll
        for (int ai = 0; ai < 2; ++ai)
#pragma unroll
            for (int m = 0; m < 4; ++m) {
                bf16_t* rowp = base + (size_t)(row0 + ai * HALF + m * 16) * ldc + col0;
#pragma unroll
                for (int bj = 0; bj < 2; ++bj) {
                    f32x4 v0 = acc[ai][bj][m][0], v1 = acc[ai][bj][m][1];
                    if (act) {
#pragma unroll
                        for (int j = 0; j < 4; ++j) { v0[j] = siluf_(v0[j]); v1[j] = siluf_(v1[j]); }
                    }
                    if (grp) { const int cc = col0 + bj * HALF; store8(base + ((size_t)(cc >> 4) * T + (row0 + ai * HALF + m * 16)) * 16 + (cc & 15), v0, v1); }
                    else store8(rowp + bj * HALF, v0, v1);
                }
            }
    }
};
struct EpiRes {
    static constexpr bool PERM = false;
    const float* base; float* out; const float* gate;
    __device__ __forceinline__ void operator()(f32x4 (&acc)[2][2][4][2], const Unit& u, int wr, int wc, int fr, int fq, LAS unsigned char* lds) const {
        const int b = (u.pm * BM) / SEQ;
        const int row0 = u.pm * BM + wr * 64 + fr, col0 = u.pn * BM + wc * 32 + 4 * fq;
        f32x4 gv[2][2];
#pragma unroll
        for (int bj = 0; bj < 2; ++bj)
#pragma unroll
            for (int n = 0; n < 2; ++n) gv[bj][n] = *(const f32x4*)(gate + b * 3072 + col0 + bj * HALF + n * 16);
#pragma unroll
        for (int ai = 0; ai < 2; ++ai) {
            f32x4 xv[4][2][2];
#pragma unroll
            for (int m = 0; m < 4; ++m) {
                const size_t off = (size_t)(row0 + ai * HALF + m * 16) * 1024 + col0;
#pragma unroll
                for (int bj = 0; bj < 2; ++bj)
#pragma unroll
                    for (int n = 0; n < 2; ++n) xv[m][bj][n] = *(const f32x4*)(base + off + bj * HALF + n * 16);
            }
#pragma unroll
            for (int m = 0; m < 4; ++m) {
                const size_t off = (size_t)(row0 + ai * HALF + m * 16) * 1024 + col0;
#pragma unroll
                for (int bj = 0; bj < 2; ++bj)
#pragma unroll
                    for (int n = 0; n < 2; ++n) *(f32x4*)(out + off + bj * HALF + n * 16) = xv[m][bj][n] + gv[bj][n] * acc[ai][bj][m][n];
            }
            asm volatile("" ::: "memory");
        }
    }
};
struct EpiResA {
    static constexpr bool PERM = true;
    const float* base; bf16_t* out; const float* gate;
    __device__ __forceinline__ void operator()(f32x4 (&acc)[2][2][4][2], const Unit& u, int wr, int wc, int fr, int fq, LAS unsigned char* lds) const {
        const int b = (u.pm * BM) / SEQ;
        const int row0 = u.pm * BM + wr * 64 + fr, col0 = u.pn * BM + wc * 32 + 8 * fq;
        f32x4 gv[2][2];
#pragma unroll
        for (int bj = 0; bj < 2; ++bj)
#pragma unroll
            for (int n = 0; n < 2; ++n) gv[bj][n] = *(const f32x4*)(gate + b * 3072 + col0 + bj * HALF + 4 * n);
#pragma unroll
        for (int ai = 0; ai < 2; ++ai) {
            f32x4 xv[4][2][2];
#pragma unroll
            for (int m = 0; m < 4; ++m) {
                const size_t off = (size_t)(row0 + ai * HALF + m * 16) * 1024 + col0;
#pragma unroll
                for (int bj = 0; bj < 2; ++bj)
#pragma unroll
                    for (int n = 0; n < 2; ++n) xv[m][bj][n] = *(const f32x4*)(base + off + bj * HALF + 4 * n);
            }
#pragma unroll
            for (int m = 0; m < 4; ++m) {
                const size_t off = (size_t)(row0 + ai * HALF + m * 16) * 1024 + col0;
#pragma unroll
                for (int bj = 0; bj < 2; ++bj) store8(out + off + bj * HALF, xv[m][bj][0] + gv[bj][0] * acc[ai][bj][m][0], xv[m][bj][1] + gv[bj][1] * acc[ai][bj][m][1]);
            }
            asm volatile("" ::: "memory");
        }
    }
};
struct EpiResB {
    static constexpr bool PERM = true;
    const bf16_t* base; float* out; const float* gate;
    __device__ __forceinline__ void operator()(f32x4 (&acc)[2][2][4][2], const Unit& u, int wr, int wc, int fr, int fq, LAS unsigned char* lds) const {
        const int b = (u.pm * BM) / SEQ;
        const int row0 = u.pm * BM + wr * 64 + fr, col0 = u.pn * BM + wc * 32 + 8 * fq;
        f32x4 gv[2][2];
#pragma unroll
        for (int bj = 0; bj < 2; ++bj)
#pragma unroll
            for (int n = 0; n < 2; ++n) gv[bj][n] = *(const f32x4*)(gate + b * 3072 + col0 + bj * HALF + 4 * n);
#pragma unroll
        for (int ai = 0; ai < 2; ++ai) {
            u32x4 xw[4][2];
#pragma unroll
            for (int m = 0; m < 4; ++m) {
                const size_t off = (size_t)(row0 + ai * HALF + m * 16) * 1024 + col0;
#pragma unroll
                for (int bj = 0; bj < 2; ++bj) xw[m][bj] = *(const u32x4*)(base + off + bj * HALF);
            }
#pragma unroll
            for (int m = 0; m < 4; ++m) {
                const size_t off = (size_t)(row0 + ai * HALF + m * 16) * 1024 + col0;
#pragma unroll
                for (int bj = 0; bj < 2; ++bj) {
                    const u32x4 w = xw[m][bj];
                    const f32x4 x0 = (f32x4){bflo(w.x), bfhi(w.x), bflo(w.y), bfhi(w.y)}, x1 = (f32x4){bflo(w.z), bfhi(w.z), bflo(w.w), bfhi(w.w)};
                    *(f32x4*)(out + off + bj * HALF) = x0 + gv[bj][0] * acc[ai][bj][m][0];
                    *(f32x4*)(out + off + bj * HALF + 4) = x1 + gv[bj][1] * acc[ai][bj][m][1];
                }
            }
            asm volatile("" ::: "memory");
        }
    }
};
struct EpiGlu {
    static constexpr bool PERM = true;
    const bf16_t* Y; const bf16_t* SG; bf16_t* O; const float* bias;
    __device__ __forceinline__ void operator()(f32x4 (&acc)[2][2][4][2], const Unit& u, int wr, int wc, int fr, int fq, LAS unsigned char* lds) const {
        const int row0 = u.pm * BM + wr * 64 + fr, col0 = u.pn * BM + wc * 32 + 8 * fq;
        f32x4 bv[2][2];
#pragma unroll
        for (int bj = 0; bj < 2; ++bj)
#pragma unroll
            for (int n = 0; n < 2; ++n) bv[bj][n] = *(const f32x4*)(bias + col0 + bj * HALF + 4 * n);
#pragma unroll
        for (int ai = 0; ai < 2; ++ai) {
            u32x4 ywv[4][2], swv[4][2];
#pragma unroll
            for (int m = 0; m < 4; ++m) {
                const size_t off = (size_t)(row0 + ai * HALF + m * 16) * 1024 + col0;
#pragma unroll
                for (int bj = 0; bj < 2; ++bj) { ywv[m][bj] = *(const u32x4*)(Y + off + bj * HALF); swv[m][bj] = *(const u32x4*)(SG + off + bj * HALF); }
            }
#pragma unroll
            for (int m = 0; m < 4; ++m) {
                const size_t off = (size_t)(row0 + ai * HALF + m * 16) * 1024 + col0;
#pragma unroll
                for (int bj = 0; bj < 2; ++bj) {
                    const u32x4 yw = ywv[m][bj], sw = swv[m][bj];
                    const f32x4 z0 = acc[ai][bj][m][0] + bv[bj][0], z1 = acc[ai][bj][m][1] + bv[bj][1];
                    f32x4 v0, v1;
                    v0[0] = bflo(yw.x) * bflo(sw.x) * sigmoidf_(z0[0]); v0[1] = bfhi(yw.x) * bfhi(sw.x) * sigmoidf_(z0[1]);
                    v0[2] = bflo(yw.y) * bflo(sw.y) * sigmoidf_(z0[2]); v0[3] = bfhi(yw.y) * bfhi(sw.y) * sigmoidf_(z0[3]);
                    v1[0] = bflo(yw.z) * bflo(sw.z) * sigmoidf_(z1[0]); v1[1] = bfhi(yw.z) * bfhi(sw.z) * sigmoidf_(z1[1]);
                    v1[2] = bflo(yw.w) * bflo(sw.w) * sigmoidf_(z1[2]); v1[3] = bfhi(yw.w) * bfhi(sw.w) * sigmoidf_(z1[3]);
                    store8(O + off + bj * HALF, v0, v1);
                }
            }
            asm volatile("" ::: "memory");
        }
    }
};
}

__device__ __forceinline__ void p0_transpose_item(const float* W, int N, bf16_t* WT, int ldk, int row_off, LAS float* scr, int kb, int nb, int lane) {
    const int k0 = 64 * kb, n0 = 32 * nb;
#pragma unroll 8
    for (int i = 0; i < 32; ++i) { const int kk = 2 * i + (lane >> 5); scr[kk * 33 + (lane & 31)] = W[(size_t)(k0 + kk) * N + n0 + (lane & 31)]; }
    LDS_WAIT();
    const int c = lane & 7;
#pragma unroll
    for (int j = 0; j < 4; ++j) { const int n = (lane >> 3) + 8 * j; const LAS float* s = scr + (8 * c) * 33 + n;
        u32x4 o; o.x = cvt_pk_bf16(s[0 * 33], s[1 * 33]); o.y = cvt_pk_bf16(s[2 * 33], s[3 * 33]); o.z = cvt_pk_bf16(s[4 * 33], s[5 * 33]); o.w = cvt_pk_bf16(s[6 * 33], s[7 * 33]);
        *(u32x4*)(WT + (size_t)(row_off + n0 + n) * ldk + k0 + 8 * c) = o; }
    LDS_WAIT();
}

__device__ __forceinline__ void p0_prologue(const Params& p, LAS unsigned char* lds) {
    int tidl_ = threadIdx.x; asm volatile("" : "+v"(tidl_));
    const int tid = tidl_, wave = tid >> 6, lane = tid & 63, G = gridDim.x;
    unsigned char* ws = p.ws;
    for (int it = blockIdx.x; it < 96; it += G) {
        LAS float* sc = (LAS float*)lds;
        LAS float* red = (LAS float*)(lds + 16384);
        const float* c = p.in[1];
        for (int i = tid; i < 4096; i += 512) { const float v = c[i]; sc[i] = v / (1.0f + expf(-v)); }
        __syncthreads();
        const int l = it / 48, n0 = (it % 48) * 64;
        const float* w = p.in[3] + (size_t)l * 1024 * 3072 + n0 + lane;
        float a0 = 0.f, a1 = 0.f, a2 = 0.f, a3 = 0.f;
#pragma unroll 8
        for (int kk = 0; kk < 128; ++kk) { const int k = wave * 128 + kk; const float wv = w[(size_t)k * 3072];
            a0 += wv * sc[k]; a1 += wv * sc[1024 + k]; a2 += wv * sc[2048 + k]; a3 += wv * sc[3072 + k]; }
        red[(wave * 4 + 0) * 64 + lane] = a0; red[(wave * 4 + 1) * 64 + lane] = a1; red[(wave * 4 + 2) * 64 + lane] = a2; red[(wave * 4 + 3) * 64 + lane] = a3;
        __syncthreads();
        if (tid < 256) { const int b = tid >> 6; float s = p.in[4][l * 3072 + n0 + lane];
#pragma unroll
            for (int w8 = 0; w8 < 8; ++w8) s += red[(w8 * 4 + b) * 64 + lane];
            ((float*)(ws + WS_MOD))[(l * 4 + b) * 3072 + n0 + lane] = s; }
        __syncthreads();
    }
}
__device__ __forceinline__ void p0_weights(const Params& p, LAS unsigned char* lds) {
    int tidl_ = threadIdx.x; asm volatile("" : "+v"(tidl_));
    const int tid = tidl_, wave = tid >> 6, lane = tid & 63, G = gridDim.x;
    unsigned char* ws = p.ws;
    {
        const int idx = (int)(gridDim.x - 1 - blockIdx.x) * 512 + tid;
        if (idx < 4096) {
            const int g = idx >> 6, pp = idx & 63;
            const double dt = exp((double)p.in[19][g]);
            const double lr = (double)p.in[17][idx], li = (double)p.in[18][idx];
            const double decay = exp(lr * dt), ang = li * dt;
            const double are = decay * cos(ang), aim = decay * sin(ang);
            const double den = lr * lr + li * li, nre = are - 1.0;
            const double cre = (nre * lr + aim * li) / den, cim = (aim * lr - nre * li) / den;
            float* AB = (float*)(ws + WS_ABAR); float* ABL = (float*)(ws + WS_ABARL);
            AB[idx * 2] = (float)are; AB[idx * 2 + 1] = (float)aim;
            { const double d16 = exp(lr * dt * 16.0), a16 = ang * 16.0; float* AB16 = (float*)(ws + WS_AB16); AB16[idx * 2] = (float)(d16 * cos(a16)); AB16[idx * 2 + 1] = (float)(d16 * sin(a16)); }
            const double dl = exp(lr * dt * S5_LC), al = ang * S5_LC;
            ABL[idx * 2] = (float)(dl * cos(al)); ABL[idx * 2 + 1] = (float)(dl * sin(al));
            bf16_t* BBM = (bf16_t*)(ws + WS_BBM); bf16_t* CM = (bf16_t*)(ws + WS_CM);
            for (int ch = 0; ch < 16; ++ch) {
                const double br = (double)p.in[20][(size_t)idx * 16 + ch], bi = (double)p.in[21][(size_t)idx * 16 + ch];
                BBM[((size_t)g * 128 + pp) * 16 + ch] = (bf16_t)f2bf((float)(cre * br - cim * bi));
                BBM[((size_t)g * 128 + 64 + pp) * 16 + ch] = (bf16_t)f2bf((float)(cre * bi + cim * br));
                CM[((size_t)g * 16 + ch) * 128 + 2 * pp] = (bf16_t)f2bf(p.in[22][((size_t)g * 16 + ch) * 64 + pp]);
                CM[((size_t)g * 16 + ch) * 128 + 2 * pp + 1] = (bf16_t)f2bf(-p.in[23][((size_t)g * 16 + ch) * 64 + pp]);
            }
        }
    }
    {
        LAS float* scr = (LAS float*)(lds + wave * 16384);
        const int nmod = (G > 128) ? 96 : 0;
        const int gw = ((int)blockIdx.x - nmod) * 8 + wave, NGW = (G - nmod) * 8;
        constexpr int I0 = 16 * 192, I1 = 32 * 32, I2 = 16 * 64, I3 = 16 * 32, I4 = 16 * 32, I5 = 64, I6 = 64;
        constexpr int NIT = I0 + I1 + I2 + I3 + I4 + I5 + I6;
        if (gw >= 0) for (int it = gw; it < NIT; it += NGW) {
            int r = it;
            if (r < I0) { const int kb = r / 192, nb = r % 192; const int n0 = nb * 32, seg = n0 >> 10; const int dseg = seg == 4 ? 5 : (seg == 5 ? 4 : seg);
                p0_transpose_item(p.in[5], 6144, (bf16_t*)(ws + WS_WINE), 1024, (dseg - seg) * 1024, scr, kb, nb, lane); continue; } r -= I0;
            if (r < I1) { p0_transpose_item(p.in[15], 1024, (bf16_t*)(ws + WS_WOUTE), 2048, 0, scr, r / 32, r % 32, lane); continue; } r -= I1;
            if (r < I2) { p0_transpose_item(p.in[16], 2048, (bf16_t*)(ws + WS_WINO), 1024, 0, scr, r / 64, r % 64, lane); continue; } r -= I2;
            if (r < I3) { p0_transpose_item(p.in[25], 1024, (bf16_t*)(ws + WS_WGLU), 1024, 0, scr, r / 32, r % 32, lane); continue; } r -= I3;
            if (r < I4) { p0_transpose_item(p.in[27], 1024, (bf16_t*)(ws + WS_WOUTO), 1024, 0, scr, r / 32, r % 32, lane); continue; } r -= I4;
            if (r < I5) { const int hh = r >> 3, q = r & 7; p0_transpose_item(p.in[8] + (size_t)hh * 16384, 128, (bf16_t*)(ws + WS_WG) + (size_t)hh * 256 * 128, 128, 0, scr, q >> 2, q & 3, lane); continue; } r -= I5;
            { const int hh = r >> 3, q = r & 7; p0_transpose_item(p.in[10] + (size_t)hh * 16384, 128, (bf16_t*)(ws + WS_WG) + (size_t)hh * 256 * 128, 128, 128, scr, q >> 2, q & 3, lane); }
        }
    }
}

__device__ __forceinline__ void norm_phase(const float* x, const float* ng, const float* mod, bf16_t* H) {
    int tidl_ = threadIdx.x; asm volatile("" : "+v"(tidl_));
    const int tid = tidl_, wave = tid >> 6, lane = tid & 63;
    const int gw = blockIdx.x * 8 + wave, NGW = gridDim.x * 8;
    const int m0 = gw * 2, m1 = T;
    int curb = -1; f32x4 ca[4], cb[4];
    for (int m = m0; m < m1; m += NGW * 2) {
        const int b = m / SEQ;
        const bool two = (m + 1 < m1) && ((m + 1) / SEQ == b);
        if (b != curb) { curb = b;
#pragma unroll
            for (int j = 0; j < 4; ++j) { const int col = 4 * lane + 256 * j;
                const f32x4 g = *(const f32x4*)(ng + col), sc = *(const f32x4*)(mod + b * 3072 + 1024 + col);
                ca[j] = g * (sc + 1.0f); cb[j] = *(const f32x4*)(mod + b * 3072 + col); } }
        const f32x4* xr = (const f32x4*)(x + (size_t)m * D) + lane;
        const f32x4* xr2 = two ? xr + D / 4 : xr;
        f32x4 v[4], v2[4]; float ss = 0.f, ss2 = 0.f;
#pragma unroll
        for (int j = 0; j < 4; ++j) { v[j] = xr[64 * j]; v2[j] = xr2[64 * j]; }
#pragma unroll
        for (int j = 0; j < 4; ++j) { ss += (v[j][0] * v[j][0] + v[j][1] * v[j][1]) + (v[j][2] * v[j][2] + v[j][3] * v[j][3]);
            ss2 += (v2[j][0] * v2[j][0] + v2[j][1] * v2[j][1]) + (v2[j][2] * v2[j][2] + v2[j][3] * v2[j][3]); }
        const float rstd = 1.0f / sqrtf(wave_sum(ss) * (1.0f / D) + EPS), rstd2 = 1.0f / sqrtf(wave_sum(ss2) * (1.0f / D) + EPS);
        u32x2* o8 = (u32x2*)(H + (size_t)m * D) + lane;
#pragma unroll
        for (int j = 0; j < 4; ++j) { const f32x4 h = v[j] * rstd * ca[j] + cb[j]; u32x2 w; w.x = cvt_pk_bf16(h[0], h[1]); w.y = cvt_pk_bf16(h[2], h[3]); o8[64 * j] = w; }
        if (two) {
            u32x2* o82 = o8 + D / 4;
#pragma unroll
            for (int j = 0; j < 4; ++j) { const f32x4 h = v2[j] * rstd2 * ca[j] + cb[j]; u32x2 w; w.x = cvt_pk_bf16(h[0], h[1]); w.y = cvt_pk_bf16(h[2], h[3]); o82[64 * j] = w; }
        }
    }
}

__device__ __forceinline__ void norm_phase_bf16(const bf16_t* x, const float* ng, const float* mod, bf16_t* Hh) {
    int tidl_ = threadIdx.x; asm volatile("" : "+v"(tidl_));
    const int tid = tidl_, wave = tid >> 6, lane = tid & 63;
    const int gw = blockIdx.x * 8 + wave, NGW = gridDim.x * 8;
    const int m0 = gw * 4, m1 = T;
    int curb = -1; f32x4 ca[4], cb[4];
    for (int m = m0; m < m1; m += NGW * 4) {
        const int b = m / SEQ;
        if (b != curb) { curb = b;
#pragma unroll
            for (int j = 0; j < 4; ++j) { const int col = 8 * lane + 512 * (j >> 1) + 4 * (j & 1);
                const f32x4 g = *(const f32x4*)(ng + col), sc = *(const f32x4*)(mod + b * 3072 + 1024 + col);
                ca[j] = g * (sc + 1.0f); cb[j] = *(const f32x4*)(mod + b * 3072 + col); } }
        u32x4 v[4][2];
#pragma unroll
        for (int r = 0; r < 4; ++r) { const int mr = (m + r < m1) ? m + r : m; const u32x4* xr = (const u32x4*)(x + (size_t)mr * D) + lane; v[r][0] = xr[0]; v[r][1] = xr[64]; }
#pragma unroll
        for (int r = 0; r < 4; ++r) {
            f32x4 f[4];
#pragma unroll
            for (int hh = 0; hh < 2; ++hh) { const u32x4 w = v[r][hh]; f[2 * hh] = (f32x4){bflo(w.x), bfhi(w.x), bflo(w.y), bfhi(w.y)}; f[2 * hh + 1] = (f32x4){bflo(w.z), bfhi(w.z), bflo(w.w), bfhi(w.w)}; }
            float ss = 0.f;
#pragma unroll
            for (int j = 0; j < 4; ++j) ss += (f[j][0] * f[j][0] + f[j][1] * f[j][1]) + (f[j][2] * f[j][2] + f[j][3] * f[j][3]);
            const float rstd = 1.0f / sqrtf(wave_sum(ss) * (1.0f / D) + EPS);
            if (m + r < m1) {
                u32x4* o16 = (u32x4*)(Hh + (size_t)(m + r) * D) + lane;
#pragma unroll
                for (int hh = 0; hh < 2; ++hh) { const f32x4 h0 = f[2 * hh] * rstd * ca[2 * hh] + cb[2 * hh], h1 = f[2 * hh + 1] * rstd * ca[2 * hh + 1] + cb[2 * hh + 1];
                    u32x4 w; w.x = cvt_pk_bf16(h0[0], h0[1]); w.y = cvt_pk_bf16(h0[2], h0[3]); w.z = cvt_pk_bf16(h1[0], h1[1]); w.w = cvt_pk_bf16(h1[2], h1[3]); o16[64 * hh] = w; }
            }
        }
    }
}

__device__ __forceinline__ void attn_unit(LAS unsigned char* lds, const bf16_t* Qm, const bf16_t* Km, const bf16_t* VT, const bf16_t* GBm, bf16_t* YB, int b, int hp, int qb) {
    int tidl_ = threadIdx.x; asm volatile("" : "+v"(tidl_));
    const int tid = tidl_, wave = tid >> 6, lane = tid & 63, fr = lane & 15, fq = lane >> 4;
    const int hsel = wave >> 2, h = 2 * hp + hsel;
    const int q0 = qb * 64, qw = q0 + (hsel ? 3 - (wave & 3) : (wave & 3)) * 16;
    const size_t rowbase = (size_t)b * SEQ;
    LAS unsigned char* KL = lds + hsel * 35840;
    LAS unsigned char* VL = KL + 17408;
    volatile LAS int* FL = (volatile LAS int*)(lds + 71680);
    bf16x8 qf[4];
    { const bf16_t* qp = Qm + (rowbase + qw + fr) * 1024 + h * 128 + fq * 8;
#pragma unroll
      for (int ks = 0; ks < 4; ++ks) qf[ks] = *(const bf16x8*)(qp + ks * 32); }
    f32x4 o[8];
#pragma unroll
    for (int d = 0; d < 8; ++d) o[d] = (f32x4){0.f, 0.f, 0.f, 0.f};
    float Rs = 1.f;
    int kb = q0 >> 6;
    u32x4 pk[4], pv[4];
#define ATT_LOAD(kbi) do { const int k0_ = (kbi) * 64; _Pragma("unroll") for (int i_ = 0; i_ < 4; ++i_) { const int ci = (tid + 512 * i_) & 1023, hh_ = 2 * hp + (i_ >> 1); \
        pk[i_] = *(const u32x4*)(Km + (rowbase + k0_ + (ci >> 4)) * 1024 + hh_ * 128 + (ci & 15) * 8); \
        pv[i_] = *(const u32x4*)(VT + (size_t)(hh_ * 128 + (ci >> 3)) * T + rowbase + k0_ + (ci & 7) * 8); } } while (0)
    ATT_LOAD(kb);
    int it = 0;
    for (;;) {
#pragma unroll
        for (int i = 0; i < 4; ++i) { const int ci = (tid + 512 * i) & 1023; LAS unsigned char* kd = lds + (i >> 1) * 35840;
            *(LAS u32x4*)(kd + (ci >> 4) * 272 + (ci & 15) * 16) = pk[i];
            *(LAS u32x4*)(kd + 17408 + (ci >> 3) * 144 + (ci & 7) * 16) = pv[i]; }
        __syncthreads();
        if (kb > 0) ATT_LOAD(kb - 1);
        const int k0 = kb * 64;
        if (k0 < qw + 15 && !__all(Rs == 0.f)) {
            f32x4 s[4];
#pragma unroll
            for (int rb = 0; rb < 4; ++rb) {
                const int c = rb >> 1, e = rb & 1;
                const int kl = 32 * c + (fr >> 2) * 8 + e * 4 + (fr & 3);
                s[rb] = (f32x4){0.f, 0.f, 0.f, 0.f};
#pragma unroll
                for (int ks = 0; ks < 4; ++ks) {
                    const bf16x8 a = *(const LAS bf16x8*)(KL + kl * 272 + (ks * 32 + fq * 8) * 2);
                    s[rb] = __builtin_amdgcn_mfma_f32_16x16x32_bf16(a, qf[ks], s[rb], 0, 0, 0);
                }
            }
            const int qi = qw + fr;
            float be[2][8], om[2][8];
#pragma unroll
            for (int c = 0; c < 2; ++c)
#pragma unroll
                for (int i = 0; i < 8; ++i) {
                    const float z = s[2 * c + (i >> 2)][i & 3];
                    const int key = k0 + 32 * c + 8 * fq + i;
                    const float e = __builtin_amdgcn_exp2f(-fabsf(z));
                    const float r = __builtin_amdgcn_rcpf(1.0f + e);
                    const bool pos = z >= 0.f, valid = key < qi;
                    be[c][i] = valid ? (pos ? r : e * r) : 0.f;
                    om[c][i] = valid ? (pos ? e * r : r) : 1.f;
                }
            float suf[2][8], Gs[2], Tt[2];
#pragma unroll
            for (int c = 0; c < 2; ++c) {
                float run = 1.f;
#pragma unroll
                for (int i = 7; i >= 0; --i) { suf[c][i] = run; run *= om[c][i]; }
                const float t1 = __shfl(run, (lane + 16) & 63), t2 = __shfl(run, (lane + 32) & 63), t3 = __shfl(run, (lane + 48) & 63);
                Gs[c] = (fq < 3 ? t1 : 1.f) * (fq < 2 ? t2 : 1.f) * (fq < 1 ? t3 : 1.f);
                Tt[c] = (run * t1) * (t2 * t3);
            }
            bf16x8 pf[2];
#pragma unroll
            for (int c = 0; c < 2; ++c) {
                const float basec = Rs * Gs[c] * (c == 0 ? Tt[1] : 1.f);
                float w[8];
#pragma unroll
                for (int i = 0; i < 8; ++i) w[i] = be[c][i] * (suf[c][i] * basec);
                u32x4 pw; pw.x = cvt_pk_bf16(w[0], w[1]); pw.y = cvt_pk_bf16(w[2], w[3]); pw.z = cvt_pk_bf16(w[4], w[5]); pw.w = cvt_pk_bf16(w[6], w[7]);
                pf[c] = __builtin_bit_cast(bf16x8, pw);
            }
            Rs *= Tt[0] * Tt[1];
#pragma unroll
            for (int db = 0; db < 8; ++db)
#pragma unroll
                for (int c = 0; c < 2; ++c) {
                    const bf16x8 a = *(const LAS bf16x8*)(VL + (db * 16 + fr) * 144 + (32 * c + 8 * fq) * 2);
                    o[db] = __builtin_amdgcn_mfma_f32_16x16x32_bf16(a, pf[c], o[db], 0, 0, 0);
                }
        }
        const bool wdone = __all(Rs == 0.f);
        if (lane == 0) FL[(it & 1) * 8 + wave] = wdone ? 1 : 0;
        __syncthreads();
        int alld = 1;
#pragma unroll
        for (int w8 = 0; w8 < 8; ++w8) alld &= FL[(it & 1) * 8 + w8];
        if (alld || kb == 0) break;
        --kb; ++it;
    }
#undef ATT_LOAD
    {
        const size_t off = (rowbase + qw + fr) * 1024 + h * 128 + fq * 4;
#pragma unroll
        for (int db = 0; db < 8; ++db) {
            const u32x2 gw = *(const u32x2*)(GBm + off + db * 16);
            u32x2 w; w.x = cvt_pk_bf16(o[db][0] * bflo(gw.x), o[db][1] * bfhi(gw.x)); w.y = cvt_pk_bf16(o[db][2] * bflo(gw.y), o[db][3] * bfhi(gw.y));
            *(u32x2*)(YB + off + db * 16) = w;
        }
    }
    __syncthreads();
}

template <bool PASSB>
__device__ __forceinline__ void lru_unit(LAS unsigned char* lds, const Params& p, int b, int hd, int chunk) {
    int tidl_ = threadIdx.x; asm volatile("" : "+v"(tidl_));
    const int tid = tidl_, wave = tid >> 6, lane = tid & 63, fr = lane & 15, fq = lane >> 4;
    unsigned char* ws = p.ws;
    const bf16_t* XA = (const bf16_t*)(ws + WS_XA); const bf16_t* GA = (const bf16_t*)(ws + WS_GA); bf16_t* YA = (bf16_t*)(ws + WS_Q);
    const bf16_t* WG = (const bf16_t*)(ws + WS_WG); float* AGG = (float*)(ws + WS_LAGG);
    bf16x8 wf[2][4];
#pragma unroll
    for (int gs = 0; gs < 2; ++gs)
#pragma unroll
        for (int ks = 0; ks < 4; ++ks) wf[gs][ks] = *(const bf16x8*)(WG + ((size_t)hd * 256 + gs * 128 + wave * 16 + fr) * 128 + ks * 32 + fq * 8);
    const int gch = hd * 128 + wave * 16 + fr, chl = wave * 16 + fr;
    const float brv = p.in[9][gch], biv = p.in[11][gch];
    float clv; { const float L = p.in[12][gch]; clv = -8.0f * (fmaxf(-L, 0.f) + log1pf(expf(-fabsf(L)))); }
    const int ch8 = (tid & 15) * 8, tok = tid >> 4;
    float Cst = 0.f, Pacc = 1.f;
    if (PASSB) {
        f32x2 e[LRU_NC];
#pragma unroll
        for (int j = 0; j < LRU_NC - 1; ++j) { const int jj = j < chunk ? j : 0; e[j] = *(const f32x2*)(AGG + ((size_t)(b * LRU_NC + jj) * 1024 + gch) * 2); }
#pragma unroll
        for (int j = 0; j < LRU_NC - 1; ++j) if (j < chunk) Cst = e[j][0] * Cst + e[j][1];
    }
    f32x4 cw0[4], cw1[4];
#pragma unroll
    for (int k = 0; k < 4; ++k) { cw0[k] = *(const f32x4*)(p.in[6] + k * 1024 + hd * 128 + ch8); cw1[k] = *(const f32x4*)(p.in[6] + k * 1024 + hd * 128 + ch8 + 4); }
    const f32x4 cb0 = *(const f32x4*)(p.in[7] + hd * 128 + ch8), cb1 = *(const f32x4*)(p.in[7] + hd * 128 + ch8 + 4);
    u32x4 xw[2][4];
    const bf16_t* xbase = XA + ((size_t)b * SEQ) * 1024 + hd * 128 + ch8;
#define LRU_LOADX(st_) do { const int t0_ = chunk * LRU_LC + (st_) * 64; _Pragma("unroll") for (int i_ = 0; i_ < 2; ++i_) _Pragma("unroll") for (int k_ = 0; k_ < 4; ++k_) { \
        const int ts_ = t0_ + tok + 32 * i_ - 3 + k_; xw[i_][k_] = (ts_ >= 0) ? *(const u32x4*)(xbase + (size_t)ts_ * 1024) : (u32x4){0u, 0u, 0u, 0u}; } } while (0)
    LRU_LOADX(0);
    constexpr int NST = LRU_LC / 64;
    for (int st = 0; st < NST; ++st) {
        const int t0 = chunk * LRU_LC + st * 64;
        LAS unsigned char* XCB = lds + (st & 1) * 51200;
        LAS float* XCF = (LAS float*)(XCB + 17408);
#pragma unroll
        for (int i = 0; i < 2; ++i) {
            const int token = tok + 32 * i;
            f32x4 a0 = cb0, a1 = cb1;
#pragma unroll
            for (int k = 0; k < 4; ++k) {
                const u32x4 x4 = xw[i][k];
                a0[0] += cw0[k][0] * bflo(x4.x); a0[1] += cw0[k][1] * bfhi(x4.x); a0[2] += cw0[k][2] * bflo(x4.y); a0[3] += cw0[k][3] * bfhi(x4.y);
                a1[0] += cw1[k][0] * bflo(x4.z); a1[1] += cw1[k][1] * bfhi(x4.z); a1[2] += cw1[k][2] * bflo(x4.w); a1[3] += cw1[k][3] * bfhi(x4.w);
            }
            u32x4 w; w.x = cvt_pk_bf16(a0[0], a0[1]); w.y = cvt_pk_bf16(a0[2], a0[3]); w.z = cvt_pk_bf16(a1[0], a1[1]); w.w = cvt_pk_bf16(a1[2], a1[3]);
            *(LAS u32x4*)(XCB + (((token >> 2) & 3) * 16 + (token >> 4) * 4 + (token & 3)) * 272 + ch8 * 2) = w;
            *(LAS f32x4*)(XCF + token * 132 + ch8) = a0; *(LAS f32x4*)(XCF + token * 132 + ch8 + 4) = a1;
        }
        __syncthreads();
        if (st + 1 < NST) LRU_LOADX(st + 1);
        const size_t obase = ((size_t)b * SEQ + t0 + fq * 16) * 1024 + hd * 128 + chl;
        unsigned short gvv[16];
        if (PASSB) {
#pragma unroll
            for (int q = 0; q < 16; ++q) gvv[q] = GA[obase + (size_t)q * 1024];
        }
        float hl[16], pl[16];
        float hrun = 0.f, prun = 1.f;
#pragma unroll
        for (int tb = 0; tb < 4; ++tb) {
            f32x4 ar = (f32x4){0.f, 0.f, 0.f, 0.f}, ai = (f32x4){0.f, 0.f, 0.f, 0.f};
#pragma unroll
            for (int ks = 0; ks < 4; ++ks) {
                const bf16x8 a = *(const LAS bf16x8*)(XCB + (tb * 16 + fr) * 272 + (ks * 32 + fq * 8) * 2);
                ar = __builtin_amdgcn_mfma_f32_16x16x32_bf16(a, wf[0][ks], ar, 0, 0, 0);
                ai = __builtin_amdgcn_mfma_f32_16x16x32_bf16(a, wf[1][ks], ai, 0, 0, 0);
            }
#pragma unroll
            for (int j = 0; j < 4; ++j) {
                const int token = fq * 16 + tb * 4 + j;
                const float xcv = XCF[token * 132 + chl];
                const float e1 = __expf(fminf(-(ar[j] + brv), 40.f)), e2 = __expf(fminf(-(ai[j] + biv), 40.f));
                const float inv = __builtin_amdgcn_rcpf((1.0f + e1) * (1.0f + e2));
                const float r = inv * (1.0f + e2), ig = inv * (1.0f + e1);
                const float a = __expf(clv * r);
                const float bb = __builtin_amdgcn_sqrtf(fmaxf(1.0f - a * a, 0.f)) * (ig * xcv);
                hrun = a * hrun + bb; prun *= a;
                if (PASSB) { hl[tb * 4 + j] = hrun; pl[tb * 4 + j] = prun; }
            }
        }
        const float P0 = __shfl(prun, fr), H0 = __shfl(hrun, fr), P1 = __shfl(prun, fr + 16), H1 = __shfl(hrun, fr + 16);
        const float P2 = __shfl(prun, fr + 32), H2 = __shfl(hrun, fr + 32), P3 = __shfl(prun, fr + 48), H3 = __shfl(hrun, fr + 48);
        const float s0 = P0 * Cst + H0, s1 = P1 * s0 + H1, s2 = P2 * s1 + H2, s3 = P3 * s2 + H3;
        const float cin = fq == 0 ? Cst : (fq == 1 ? s0 : (fq == 2 ? s1 : s2));
        Cst = s3;
        if (PASSB) {
#pragma unroll
            for (int q = 0; q < 16; ++q) {
                const float hv = hl[q] + pl[q] * cin;
                const float gt = __uint_as_float(((unsigned)gvv[q]) << 16);
                YA[obase + (size_t)q * 1024] = (bf16_t)(cvt_pk_bf16(hv * gt, 0.f) & 0xffffu);
            }
        } else {
            Pacc *= (P0 * P1) * (P2 * P3);
        }
    }
#undef LRU_LOADX
    if (!PASSB && fq == 0) { *(f32x2*)(AGG + ((size_t)(b * LRU_NC + chunk) * 1024 + gch) * 2) = (f32x2){Pacc, Cst}; }
    __syncthreads();
}

__device__ __forceinline__ void p0_w16(const Params& p) {
    const int idx = blockIdx.x * 512 + threadIdx.x;
    if (idx >= 64 * 64 * 16) return;
    const int g = idx >> 10, pp = (idx >> 4) & 63, sidx = idx & 15, gp = g * 64 + pp;
    const float dt = expf(p.in[19][g]);
    const float lr = p.in[17][gp], li = p.in[18][gp];
    const float x = lr * dt, ang = li * dt;
    float sn, cs; sincosf(ang, &sn, &cs);
    const float em1 = expm1f(x), sh = sinf(0.5f * ang);
    const float nre = em1 * cs - 2.0f * sh * sh, nim = (em1 + 1.0f) * sn;
    const float den = lr * lr + li * li;
    const float cre = (nre * lr + nim * li) / den, cim = (nim * lr - nre * li) / den;
    const float kf = (float)(15 - sidx);
    float sk, ck; sincosf(ang * kf, &sk, &ck);
    const float dk = expf(x * kf), pr = dk * ck, pi = dk * sk;
    const float qr = pr * cre - pi * cim, qi = pr * cim + pi * cre;
    const float* bre = p.in[20] + (size_t)gp * 16; const float* bim = p.in[21] + (size_t)gp * 16;
    unsigned wre[8], wim[8];
#pragma unroll
    for (int c2 = 0; c2 < 8; ++c2) {
        const float br0 = bre[2 * c2], bi0 = bim[2 * c2], br1 = bre[2 * c2 + 1], bi1 = bim[2 * c2 + 1];
        wre[c2] = cvt_pk_bf16(qr * br0 - qi * bi0, qr * br1 - qi * bi1);
        wim[c2] = cvt_pk_bf16(qr * bi0 + qi * br0, qr * bi1 + qi * br1);
    }
    bf16_t* W = (bf16_t*)(p.ws + WS_W16);
    u32x4* o0 = (u32x4*)(W + ((size_t)g * 128 + pp) * 256 + sidx * 16);
    u32x4* o1 = (u32x4*)(W + ((size_t)g * 128 + 64 + pp) * 256 + sidx * 16);
    o0[0] = (u32x4){wre[0], wre[1], wre[2], wre[3]}; o0[1] = (u32x4){wre[4], wre[5], wre[6], wre[7]};
    o1[0] = (u32x4){wim[0], wim[1], wim[2], wim[3]}; o1[1] = (u32x4){wim[4], wim[5], wim[6], wim[7]};
}

__device__ __forceinline__ void s5_passA_mm(LAS unsigned char* lds, const Params& p) {
    int tidl_ = threadIdx.x; asm volatile("" : "+v"(tidl_));
    const int tid = tidl_, wave = tid >> 6, lane = tid & 63, fr = lane & 15, fq = lane >> 4;
    unsigned char* ws = p.ws;
    const bf16_t* U = (const bf16_t*)(ws + WS_XA);
    const bf16_t* W16 = (const bf16_t*)(ws + WS_W16);
    float* AGG = (float*)(ws + WS_SAGG);
    const int nbg = (int)gridDim.x / 64, g = (int)blockIdx.x & 63, sub = (int)blockIdx.x >> 6;
    constexpr int NSUB = S5_LC / 16, NMB = NSUB / 16, NU = NB * S5_NC;
    static_assert(NMB == 2, "s5_passA_mm is written for 512-token chunks");
    LAS unsigned char* wl = lds;
    LAS float* incL = (LAS float*)(lds + 67584 + wave * 8448);
    if (nbg > 0 && sub < nbg) {
        for (int i = tid; i < 128 * 32; i += 512) { const int row = i >> 5, ch = i & 31;
            *(LAS u32x4*)(wl + row * 528 + ch * 16) = *(const u32x4*)(W16 + ((size_t)g * 128 + row) * 256 + ch * 8); }
    }
    __syncthreads();
    if (nbg > 0 && sub < nbg) {
        const f32x2 a16 = *(const f32x2*)((const float*)(ws + WS_AB16) + (g * 64 + lane) * 2);
        for (int uidx = sub * 8 + wave; uidx < NU; uidx += nbg * 8) {
            const int b = uidx / S5_NC, c = uidx % S5_NC;
            const size_t row0 = (size_t)b * SEQ + (size_t)c * S5_LC;
            bf16x8 af[2][8];
#pragma unroll
            for (int mb = 0; mb < 2; ++mb)
#pragma unroll
                for (int ks = 0; ks < 8; ++ks)
                    af[mb][ks] = *(const bf16x8*)(U + ((size_t)g * T + row0 + (size_t)(mb * 16 + fr) * 16 + 2 * ks + (fq >> 1)) * 16 + (fq & 1) * 8);
            float hr = 0.f, hi = 0.f;
#pragma unroll
            for (int mb = 0; mb < 2; ++mb) {
#pragma unroll
                for (int nb = 0; nb < 8; ++nb) {
                    f32x4 d = (f32x4){0.f, 0.f, 0.f, 0.f};
#pragma unroll
                    for (int ks = 0; ks < 8; ++ks) {
                        const bf16x8 bfr = *(const LAS bf16x8*)(wl + (nb * 16 + fr) * 528 + ks * 64 + fq * 16);
                        d = __builtin_amdgcn_mfma_f32_16x16x32_bf16(af[mb][ks], bfr, d, 0, 0, 0);
                    }
#pragma unroll
                    for (int j = 0; j < 4; ++j) incL[(fq * 4 + j) * 132 + nb * 16 + fr] = d[j];
                }
                LDS_WAIT();
#pragma unroll
                for (int j = 0; j < 16; ++j) {
                    const float ir = incL[j * 132 + lane], ii = incL[j * 132 + 64 + lane];
                    const float nr = fmaf(a16[0], hr, fmaf(-a16[1], hi, ir)), ni = fmaf(a16[0], hi, fmaf(a16[1], hr, ii)); hr = nr; hi = ni;
                }
                LDS_WAIT();
            }
            *(f32x2*)(AGG + ((size_t)((b * S5_NC + c) * 64 + g) * 64 + lane) * 2) = (f32x2){hr, hi};
        }
    }
    __syncthreads();
}

template <bool PASSB>
__device__ __forceinline__ void s5_phase(LAS unsigned char* lds, const Params& p) {
    int tidl_ = threadIdx.x; asm volatile("" : "+v"(tidl_));
    const int tid = tidl_, wave = tid >> 6, lane = tid & 63, fr = lane & 15, fq = lane >> 4;
    unsigned char* ws = p.ws;
    const bf16_t* U = (const bf16_t*)(ws + WS_XA); bf16_t* YG = (bf16_t*)(ws + WS_K);
    float* AGG = (float*)(ws + WS_SAGG);
    LAS float* BuL = (LAS float*)(lds + wave * 16384);
    LAS unsigned char* HbL = lds + wave * 16384 + 10240;
    const int gw = blockIdx.x * 8 + wave, NGW = gridDim.x * 8;
    constexpr int NUNIT = NB * S5_NC * 64;
    int curg = -1;
    bf16x8 bfm[8], cfm[4], dfm; float are = 0.f, aim = 0.f, alre = 0.f, alim = 0.f;
    const bf16x8 zero8 = (bf16x8){0, 0, 0, 0, 0, 0, 0, 0};
    for (int un = gw; un < NUNIT; un += NGW) {
        const int g = un & 63, c = (un >> 6) % S5_NC, b = un / (64 * S5_NC);
        if (g != curg) { curg = g;
#pragma unroll
            for (int nb = 0; nb < 8; ++nb) bfm[nb] = (fq < 2) ? *(const bf16x8*)((const bf16_t*)(ws + WS_BBM) + ((size_t)g * 128 + nb * 16 + fr) * 16 + fq * 8) : zero8;
            if (PASSB) {
#pragma unroll
                for (int ks = 0; ks < 4; ++ks) cfm[ks] = *(const bf16x8*)((const bf16_t*)(ws + WS_CM) + ((size_t)g * 16 + fr) * 128 + ks * 32 + fq * 8);
                const unsigned dbits = f2bf(p.in[24][g * 16 + fr]);
                dfm = zero8;
#pragma unroll
                for (int i = 0; i < 8; ++i) if (fq < 2 && fq * 8 + i == fr) dfm[i] = (short)dbits;
            }
            const f32x2 a = *(const f32x2*)((const float*)(ws + WS_ABAR) + (g * 64 + lane) * 2); are = a[0]; aim = a[1];
            const f32x2 al = *(const f32x2*)((const float*)(ws + WS_ABARL) + (g * 64 + lane) * 2); alre = al[0]; alim = al[1];
        }
        float hr = 0.f, hi = 0.f;
        if (PASSB) {
            for (int j0 = 0; j0 < c; j0 += 8) {
                f32x2 e[8];
#pragma unroll
                for (int i = 0; i < 8; ++i) { const int jj = (j0 + i < c) ? j0 + i : c - 1; e[i] = *(const f32x2*)(AGG + ((size_t)((b * S5_NC + jj) * 64 + g) * 64 + lane) * 2); }
#pragma unroll
                for (int i = 0; i < 8; ++i) if (j0 + i < c) { const float nr = alre * hr - alim * hi + e[i][0], ni = alre * hi + alim * hr + e[i][1]; hr = nr; hi = ni; }
            }
        }
        const size_t row0 = (size_t)b * SEQ + (size_t)c * S5_LC;
        const bf16_t* up = U + ((size_t)g * T + row0 + fr) * 16 + (fq & 1) * 8;
        bf16x8 au_n = (fq < 2) ? *(const bf16x8*)up : zero8;
        constexpr int NST = S5_LC / 16;
        for (int st = 0; st < NST; ++st) {
            const size_t r0 = row0 + st * 16;
            const bf16x8 au = au_n;
            if (st + 1 < NST) au_n = (fq < 2) ? *(const bf16x8*)(up + (size_t)(st + 1) * 16 * 16) : zero8;
#pragma unroll
            for (int nb = 0; nb < 8; ++nb) {
                const f32x4 d = __builtin_amdgcn_mfma_f32_16x16x32_bf16(au, bfm[nb], (f32x4){0.f, 0.f, 0.f, 0.f}, 0, 0, 0);
                *(LAS f32x4*)(BuL + (nb * 16 + fr) * 20 + fq * 4) = d;
            }
            LDS_WAIT();
            f32x4 br4[4], bi4[4];
#pragma unroll
            for (int q = 0; q < 4; ++q) { br4[q] = *(const LAS f32x4*)(BuL + lane * 20 + q * 4); bi4[q] = *(const LAS f32x4*)(BuL + (64 + lane) * 20 + q * 4); }
#pragma unroll
            for (int t = 0; t < 16; ++t) {
                const float bur = br4[t >> 2][t & 3], bui = bi4[t >> 2][t & 3];
                const float nr = are * hr - aim * hi + bur, ni = are * hi + aim * hr + bui; hr = nr; hi = ni;
                if (PASSB) *(LAS unsigned*)(HbL + t * 272 + lane * 4) = cvt_pk_bf16(hr, hi);
            }
            if (PASSB) {
                LDS_WAIT();
                f32x4 y = __builtin_amdgcn_mfma_f32_16x16x32_bf16(au, dfm, (f32x4){0.f, 0.f, 0.f, 0.f}, 0, 0, 0);
#pragma unroll
                for (int ks = 0; ks < 4; ++ks) {
                    const bf16x8 a = *(const LAS bf16x8*)(HbL + fr * 272 + (ks * 32 + fq * 8) * 2);
                    y = __builtin_amdgcn_mfma_f32_16x16x32_bf16(a, cfm[ks], y, 0, 0, 0);
                }
#pragma unroll
                for (int j = 0; j < 4; ++j) {
                    const float v = y[j];
                    const float ge = v * sigmoidf_(1.5957691216057308f * (v + 0.044715f * v * v * v));
                    YG[(r0 + fq * 4 + j) * 1024 + g * 16 + fr] = (bf16_t)(cvt_pk_bf16(ge, ge) & 0xffffu);
                }
            }
            LDS_WAIT();
        }
        if (!PASSB) *(f32x2*)(AGG + ((size_t)((b * S5_NC + c) * 64 + g) * 64 + lane) * 2) = (f32x2){hr, hi};
    }
}


#define XB_TMO      128
#define XB_XCNT(j)  (256  + 64 * (j))
#define XB_XSUB(j)  (1280 + 64 * (j))
#define XB_XGEN(j)  (2304 + 64 * (j))
#define XB_TOP      3328
#define XB_TOPGEN   3392
#define XCD_BAR_WORDS 3456
#define XB_SPIN_CAP (1u << 18)
__device__ __forceinline__ unsigned xb_ld(unsigned* p)              { return __hip_atomic_load(p, __ATOMIC_RELAXED, __HIP_MEMORY_SCOPE_AGENT); }
__device__ __forceinline__ unsigned xb_add(unsigned* p, unsigned v) { return __hip_atomic_fetch_add(p, v, __ATOMIC_RELAXED, __HIP_MEMORY_SCOPE_AGENT); }
__device__ __forceinline__ unsigned xb_xcc_id() { return (unsigned)__builtin_amdgcn_s_getreg((3 << 11) | 20) & 0xFu; }
#define XB_SPIN(cond, bar) do { unsigned _sp = 0; while (cond) { __builtin_amdgcn_s_sleep(1); \
    if ((++_sp & 255u) == 0u) { if (xb_ld(&(bar)[XB_TMO])) break; if (_sp > XB_SPIN_CAP) { atomicAdd(&(bar)[XB_TMO], 1u); break; } } } } while (0)
struct XcdBarrier { unsigned* bar; unsigned x; volatile LAS unsigned* st; };
__device__ __forceinline__ XcdBarrier xcd_barrier_post(unsigned* bar, volatile LAS unsigned* st) {
    XcdBarrier b; b.bar = bar; b.x = xb_xcc_id(); b.st = st;
    if (threadIdx.x == 0) (void)xb_add(&bar[XB_XCNT(b.x)], 1u);
    return b;
}
__device__ __forceinline__ void xcd_barrier_complete(unsigned* bar, unsigned x, unsigned& nloc, unsigned& nx) {
    const unsigned G = gridDim.x * gridDim.y * gridDim.z;
    unsigned sum, cnt, mine, sp = 0u;
    for (;;) {
        sum = 0u; cnt = 0u; mine = 0u;
#pragma unroll
        for (unsigned j = 0; j < 16; ++j) { const unsigned c = xb_ld(&bar[XB_XCNT(j)]); sum += c; cnt += (c > 0u) ? 1u : 0u; mine = (j == x) ? c : mine; }
        if (sum == G) break;
        __builtin_amdgcn_s_sleep(1);
        if ((++sp & 255u) == 0u) { if (xb_ld(&bar[XB_TMO])) break; if (sp > XB_SPIN_CAP) { atomicAdd(&bar[XB_TMO], 1u); break; } }
    }
    nloc = mine > 0u ? mine : 1u; nx = cnt > 0u ? cnt : 1u;
}
__device__ __forceinline__ void xcd_barrier(const XcdBarrier& b) {
    asm volatile("s_waitcnt vmcnt(0)" ::: "memory");
    __syncthreads();
    if (threadIdx.x == 0) {
        unsigned* bar = b.bar;
        const unsigned bx = xb_xcc_id();
        __builtin_amdgcn_s_waitcnt(0);
        unsigned nloc = b.st[0], nx = b.st[1];
        if (nloc == 0u) { xcd_barrier_complete(bar, bx, nloc, nx); b.st[0] = nloc; b.st[1] = nx; }
        const unsigned old = xb_add(&bar[XB_XSUB(bx)], 1u);
        const unsigned gen = old / nloc;
        if (old + 1u == (gen + 1u) * nloc) {
            __builtin_amdgcn_fence(__ATOMIC_RELEASE, "agent");
            asm volatile("s_waitcnt vmcnt(0)" ::: "memory");
            const unsigned og = xb_add(&bar[XB_TOP], 1u);
            const unsigned tg = og / nx;
            if (og + 1u == (tg + 1u) * nx) xb_add(&bar[XB_TOPGEN], 1u);
            else XB_SPIN(xb_ld(&bar[XB_TOPGEN]) == tg, bar);
            __builtin_amdgcn_fence(__ATOMIC_ACQUIRE, "agent");
            xb_add(&bar[XB_XGEN(bx)], 1u);
            asm volatile("s_waitcnt vmcnt(0)" ::: "memory");
        } else {
            XB_SPIN(xb_ld(&bar[XB_XGEN(bx)]) == gen, bar);
            __builtin_amdgcn_fence(__ATOMIC_ACQUIRE, "agent");
            asm volatile("s_waitcnt vmcnt(0)" ::: "memory");
        }
    }
    __syncthreads();
}

#define PP p
__global__ void __launch_bounds__(512, 2) fwd_megakernel(Params p) {
    extern __shared__ __attribute__((aligned(16))) unsigned char lds_raw[];
    LAS unsigned char* lds = (LAS unsigned char*)lds_raw;
    cg::grid_group grid = cg::this_grid();
    unsigned char* ws = PP.ws;
    const int G = gridDim.x;
    float* MOD = (float*)(ws + WS_MOD);
    bf16_t* H = (bf16_t*)(ws + WS_H); bf16_t* XA = (bf16_t*)(ws + WS_XA); bf16_t* GA = (bf16_t*)(ws + WS_GA);
    bf16_t* Qb = (bf16_t*)(ws + WS_Q); bf16_t* Kb = (bf16_t*)(ws + WS_K); bf16_t* VT = (bf16_t*)(ws + WS_VT); bf16_t* GB = (bf16_t*)(ws + WS_GB);

    if (threadIdx.x < 16) ((LAS unsigned*)(lds + BARST_OFF))[threadIdx.x] = 0u;
    __syncthreads();
    (void)xcd_barrier_post((unsigned*)ws, (volatile LAS unsigned*)(lds + BARST_OFF));
#define GSYNC() do { XcdBarrier xb_; xb_.bar = (unsigned*)PP.ws; xb_.x = 0; xb_.st = (volatile LAS unsigned*)(lds + BARST_OFF); xcd_barrier(xb_); } while (0)
    p0_prologue(PP, lds);
    p0_weights(PP, lds);
    p0_w16(PP);
    if (PP.ws == nullptr) grid.sync();
    GSYNC();
    norm_phase(PP.in[0], PP.in[2], MOD, H);
    GSYNC();
    for (int rep = 0; rep < REP_GALL; ++rep) {
        pg8::Gemm g{H, H, (const bf16_t*)(ws + WS_WINE), T, 5120, 1024, 1024, 16};
        pg8::StaticOrder S; S.init(T, 5120, G, (int)blockIdx.x);
        pg8::EpiInE E{XA, GA, Qb, Kb, GB, PP.in[13], PP.in[14]};
        pg8::gemm_phase<pg8::EpiInE>(lds, g, S, E);
        const bf16_t* Wv = (const bf16_t*)(ws + WS_WINE) + (size_t)5120 * 1024;
        pg8::Gemm g2{Wv, Wv, H, 1024, T, 1024, 1024, 16};
        pg8::StaticOrder S2; S2.init(1024, T, G, (int)blockIdx.x);
        pg8::EpiSeg E2{VT, nullptr, T, 0};
        pg8::gemm_phase<pg8::EpiSeg>(lds, g2, S2, E2);
    }
    GSYNC();
    {
        for (int rep = 0; rep < REP_LRU; ++rep)
        for (int un = blockIdx.x; un < NB * 8 * LRU_NC; un += G) { const int chunk = un % LRU_NC, hd = (un / LRU_NC) & 7, b = un / (LRU_NC * 8); lru_unit<false>(lds, PP, b, hd, chunk); }
        for (int rep = 0; rep < REP_ATT; ++rep)
        for (int un = blockIdx.x; un < NB * 4 * 128; un += G) { const int bh = un & 15, qb = 127 - (un >> 4); attn_unit(lds, Qb, Kb, VT, GB, H, bh >> 2, bh & 3, qb); }
    }
    GSYNC();
    for (int rep = 0; rep < REP_LRU; ++rep) {
    for (int un = blockIdx.x; un < NB * 8 * LRU_NC; un += G) { const int chunk = un % LRU_NC, hd = (un / LRU_NC) & 7, b = un / (LRU_NC * 8); lru_unit<true>(lds, PP, b, hd, chunk); }
    GSYNC(); }
    for (int rep = 0; rep < REP_GALL; ++rep) {
        pg8::Gemm g{Qb, H, (const bf16_t*)(ws + WS_WOUTE), T, 1024, 2048, 1024, 16};
        pg8::StaticOrder S; S.init(T, 1024, G, (int)blockIdx.x);
        pg8::EpiResA E{PP.in[0], GB, MOD + 2048};
        pg8::gemm_phase<pg8::EpiResA>(lds, g, S, E);
    }
    GSYNC();
    for (int rep = 0; rep < REP_NORM; ++rep) { norm_phase_bf16(GB, PP.in[2] + 1024, MOD + 4 * 3072, H);
    GSYNC(); }
    for (int rep = 0; rep < REP_G7; ++rep) {
        pg8::Gemm g{H, H, (const bf16_t*)(ws + WS_WINO), T, 2048, 1024, 1024, 16};
        pg8::StaticOrder S; S.init(T, 2048, G, (int)blockIdx.x);
        pg8::EpiSeg E{XA, GA, 1024, 3};
        pg8::gemm_phase<pg8::EpiSeg>(lds, g, S, E);
    }
    GSYNC();
    for (int rep = 0; rep < REP_S5; ++rep) { s5_passA_mm(lds, PP);
    GSYNC(); }
    for (int rep = 0; rep < REP_S5; ++rep) { s5_phase<true>(lds, PP);
    GSYNC(); }
    for (int rep = 0; rep < REP_GALL; ++rep) {
        pg8::Gemm g{Kb, Kb, (const bf16_t*)(ws + WS_WGLU), T, 1024, 1024, 1024, 16};
        pg8::StaticOrder S; S.init(T, 1024, G, (int)blockIdx.x);
        pg8::EpiGlu E{Kb, GA, VT, PP.in[26]};
        pg8::gemm_phase<pg8::EpiGlu>(lds, g, S, E);
    }
    GSYNC();
    {
        pg8::Gemm g{VT, VT, (const bf16_t*)(ws + WS_WOUTO), T, 1024, 1024, 1024, 16};
        pg8::StaticOrder S; S.init(T, 1024, G, (int)blockIdx.x);
        pg8::EpiResB E{GB, PP.out, MOD + 4 * 3072 + 2048};
        pg8::gemm_phase<pg8::EpiResB>(lds, g, S, E);
    }
}

#undef PP
extern "C" void kernel_launch(void* const* d_in, const int* in_sizes, int n_in, void* d_out, int out_size, void* d_ws, size_t ws_size, hipStream_t stream) {
    static int grid_blocks = 0;
    if (grid_blocks == 0) {
        if (n_in != 28 || out_size != T * D || ws_size < WS_END) { fprintf(stderr, "kernel_launch: unexpected shapes (n_in %d out %d ws %zu)\n", n_in, out_size, ws_size); grid_blocks = -1; return; }
        int dev = 0, cus = 0, per_cu = 0;
        hipGetDevice(&dev);
        hipDeviceGetAttribute(&cus, hipDeviceAttributeMultiprocessorCount, dev);
        if (hipFuncSetAttribute((const void*)fwd_megakernel, hipFuncAttributeMaxDynamicSharedMemorySize, LDS_BYTES) != hipSuccess) { fprintf(stderr, "kernel_launch: hipFuncSetAttribute failed\n"); grid_blocks = -1; return; }
        if (hipOccupancyMaxActiveBlocksPerMultiprocessor(&per_cu, (const void*)fwd_megakernel, 512, LDS_BYTES) != hipSuccess || per_cu < 1) { per_cu = 1; (void)hipGetLastError(); }
        grid_blocks = cus * per_cu;
    }
    if (grid_blocks < 0) return;
    if (hipMemsetAsync(d_ws, 0, 16384, stream) != hipSuccess) { fprintf(stderr, "kernel_launch: memset failed\n"); return; }
    Params p{};
    for (int i = 0; i < 28; ++i) p.in[i] = (const float*)d_in[i];
    p.out = (float*)d_out; p.ws = (unsigned char*)d_ws;
    void* args[] = {&p};
    hipError_t e = hipLaunchCooperativeKernel((const void*)fwd_megakernel, dim3(grid_blocks), dim3(512), args, LDS_BYTES, stream);
    if (e != hipSuccess) fprintf(stderr, "cooperative launch failed: %s (grid %d)\n", hipGetErrorString(e), grid_blocks);
}
```
